# Optimizing an MI355X kernel written in HIP

```python
import jax, jax.numpy as jnp
from jax import lax
import numpy as np

D_MODEL = 2048
BATCH = 8
SEQ = 4096
DEPTH = 1
DEC_BATCH = 16
DEC_SEQ = 32
PAST_LEN = 2048

CHUNK = 64
Q_BLOCK = 128
PLE_DIM = 256
MLA_HEADS = 8
MLA_Q_RANK = 512
MLA_KV_RANK = 512
MLA_NOPE = 128
MLA_ROPE = 64
MLA_V = 128
MLA_SCALE = (MLA_NOPE + MLA_ROPE) ** -0.5
ROPE_THETA = 10000.0
FOX_HEADS = 8
FOX_HEAD_DIM = 128
FOX_WIDTH = FOX_HEADS * FOX_HEAD_DIM
FOX_SCALE = FOX_HEAD_DIM ** -0.5
D_FF = 5632
CONV_W = 3
EPS = 1e-6
NEG_INF = -1e30

IN_SPLITS = (MLA_Q_RANK, MLA_KV_RANK, MLA_ROPE, FOX_WIDTH, FOX_WIDTH, FOX_WIDTH,
             FOX_HEADS, D_MODEL, D_MODEL)
IN_WIDTH = sum(IN_SPLITS)

kernel_name = "streaming_mla_fox_gated_hybrid"


def rmsnorm(x, g):
    xf = x.astype(jnp.float32)
    y = xf * lax.rsqrt(jnp.mean(xf * xf, axis=-1, keepdims=True) + EPS)
    return (y * g.astype(jnp.float32)).astype(x.dtype)


def rope(x, pos):
    half = x.shape[-1] // 2
    inv = ROPE_THETA ** (-jnp.arange(half, dtype=jnp.float32) / half)
    ang = pos.astype(jnp.float32)[:, None] * inv[None, :]
    ang = ang.reshape((ang.shape[0],) + (1,) * (x.ndim - 3) + (half,))
    cos, sin = jnp.cos(ang), jnp.sin(ang)
    xf = x.astype(jnp.float32)
    x1, x2 = xf[..., :half], xf[..., half:]
    return jnp.concatenate([x1 * cos - x2 * sin, x2 * cos + x1 * sin], axis=-1).astype(x.dtype)


def split_cols(z, widths):
    outs, o = [], 0
    for w in widths:
        outs.append(z[..., o:o + w])
        o += w
    return outs


def sweep_query_blocks(fn, q_args, qpos):
    b, t = q_args[0].shape[:2]
    nb = t // Q_BLOCK
    xs = tuple(jnp.swapaxes(a.reshape((b, nb, Q_BLOCK) + a.shape[2:]), 0, 1) for a in q_args)
    out = lax.map(lambda blk: fn(*blk[0], blk[1]), (xs, qpos.reshape(nb, Q_BLOCK)))
    return jnp.swapaxes(out, 0, 1).reshape((b, t) + out.shape[3:])


def layer(x, pe, past, w):
    b, t, _ = x.shape
    p_len = 0 if past is None else past[0].shape[1]
    qpos = p_len + jnp.arange(t)

    a = rmsnorm(x, w["g_mix"])
    cq, ckv, kr, fq, fk, fv, fl, ga, gb = split_cols(a @ w["w_in"], IN_SPLITS)
    q = (rmsnorm(cq, w["g_q"]) @ w["w_uq"]).reshape(b, t, MLA_HEADS, MLA_NOPE + MLA_ROPE)
    q_nope, q_rope = q[..., :MLA_NOPE], rope(q[..., MLA_NOPE:], qpos)
    ckv = rmsnorm(ckv, w["g_kv"])
    kr = rope(kr, qpos)
    fq = fq.reshape(b, t, FOX_HEADS, FOX_HEAD_DIM)
    fk = fk.reshape(b, t, FOX_HEADS, FOX_HEAD_DIM)
    fv = fv.reshape(b, t, FOX_HEADS, FOX_HEAD_DIM)
    logf = jax.nn.log_sigmoid((fl + w["b_f"]).astype(jnp.float32))

    if past is None:
        ckv_all, kr_all, fk_all, fv_all, logf_all = ckv, kr, fk, fv, logf
    else:
        c_ckv, c_kr, c_fk, c_fv, c_logf, _ = past
        ckv_all = jnp.concatenate([c_ckv.astype(ckv.dtype), ckv], axis=1)
        kr_all = jnp.concatenate([c_kr.astype(kr.dtype), kr], axis=1)
        fk_all = jnp.concatenate([c_fk.astype(fk.dtype), fk], axis=1)
        fv_all = jnp.concatenate([c_fv.astype(fv.dtype), fv], axis=1)
        logf_all = jnp.concatenate([c_logf.astype(jnp.float32), logf], axis=1)
    s_len = p_len + t
    kpos = jnp.arange(s_len)

    kv = (ckv_all @ w["w_ukv"]).reshape(b, s_len, MLA_HEADS, MLA_NOPE + MLA_V)
    k_nope, v_mla = kv[..., :MLA_NOPE], kv[..., MLA_NOPE:]
    kchunk = kpos // CHUNK

    def mla_fn(qn, qr, qp):
        s = (jnp.einsum('bqhd,bkhd->bhqk', qn, k_nope, preferred_element_type=jnp.float32)
             + jnp.einsum('bqhr,bkr->bhqk', qr, kr_all, preferred_element_type=jnp.float32)) * MLA_SCALE
        vis = kchunk[None, :] <= (qp // CHUNK)[:, None]
        s = jnp.where(vis, s, NEG_INF)
        pr = jax.nn.softmax(s, axis=-1).astype(v_mla.dtype)
        return jnp.einsum('bhqk,bkhd->bqhd', pr, v_mla)

    cum = jnp.cumsum(logf_all, axis=1)
    cum_q = cum[:, p_len:]
    cum_k = jnp.swapaxes(cum, 1, 2)[:, :, None, :]

    def fox_fn(qq, cq_, qp):
        s = (jnp.einsum('bqhd,bkhd->bhqk', qq, fk_all, preferred_element_type=jnp.float32) * FOX_SCALE
             + jnp.swapaxes(cq_, 1, 2)[..., None] - cum_k)
        vis = kpos[None, :] <= qp[:, None]
        s = jnp.where(vis, s, NEG_INF)
        pr = jax.nn.softmax(s, axis=-1).astype(fv_all.dtype)
        return jnp.einsum('bhqk,bkhd->bqhd', pr, fv_all)

    if past is None:
        o_a = sweep_query_blocks(mla_fn, (q_nope, q_rope), qpos)
        o_b = sweep_query_blocks(fox_fn, (fq, cum_q), qpos)
    else:
        o_a = mla_fn(q_nope, q_rope, qpos)
        o_b = fox_fn(fq, cum_q, qpos)

    merged = (jax.nn.sigmoid(ga) * (o_a.reshape(b, t, MLA_HEADS * MLA_V) @ w["w_oa"])
              + jax.nn.sigmoid(gb) * (o_b.reshape(b, t, FOX_WIDTH) @ w["w_ob"]))
    h = x + merged @ w["w_o"]

    u = rmsnorm(h, w["g_ffn"]) @ w["w_up"]
    if past is None:
        prev = jnp.zeros((b, CONV_W - 1, 2 * D_FF), u.dtype)
    else:
        prev = past[5].astype(u.dtype)
    u_pad = jnp.concatenate([prev, u], axis=1)
    uc = w["b_conv"] + sum(u_pad[:, k:k + t] * w["w_conv"][k] for k in range(CONV_W))
    val, gate = uc[..., :D_FF], uc[..., D_FF:]
    h = h + (jax.nn.gelu(gate) * val) @ w["w_down"]

    h = h + jax.nn.sigmoid(rmsnorm(h, w["g_ple"]) @ w["w_pg"]) * (pe @ w["w_ple"])

    new_state = (ckv, kr, fk, fv, logf, u_pad[:, -(CONV_W - 1):])
    return h, new_state


def setup_inputs(seed: int = 0) -> dict:
    key = jax.random.key(seed)
    ks = list(jax.random.split(key, 40))

    def nrm(k, shape, scale=1.0):
        return scale * jax.random.normal(k, shape, jnp.float32)

    def gain(k, n):
        return 1.0 + 0.1 * jax.random.normal(k, (DEPTH, n), jnp.float32)

    L = DEPTH
    return {
        "x_prompt": nrm(ks[0], (BATCH, SEQ, D_MODEL)),
        "x_sample": nrm(ks[1], (DEC_BATCH, DEC_SEQ, D_MODEL)),
        "cache_mla_ckv": nrm(ks[2], (L, DEC_BATCH, PAST_LEN, MLA_KV_RANK)),
        "cache_mla_krope": nrm(ks[3], (L, DEC_BATCH, PAST_LEN, MLA_ROPE)),
        "cache_fox_k": nrm(ks[4], (L, DEC_BATCH, PAST_LEN, FOX_HEADS, FOX_HEAD_DIM)),
        "cache_fox_v": nrm(ks[5], (L, DEC_BATCH, PAST_LEN, FOX_HEADS, FOX_HEAD_DIM)),
        "cache_fox_logf": jax.nn.log_sigmoid(2.0 + nrm(ks[6], (L, DEC_BATCH, PAST_LEN, FOX_HEADS), 0.5)),
        "state_ffn_conv": nrm(ks[7], (L, DEC_BATCH, CONV_W - 1, 2 * D_FF)),
        "p_prompt": nrm(ks[8], (L, BATCH, SEQ, PLE_DIM)),
        "p_sample": nrm(ks[9], (L, DEC_BATCH, DEC_SEQ, PLE_DIM)),
        "g_mix": gain(ks[10], D_MODEL),
        "w_in": nrm(ks[11], (L, D_MODEL, IN_WIDTH), D_MODEL ** -0.5),
        "b_f": 2.0 + nrm(ks[12], (L, FOX_HEADS), 0.5),
        "g_q": gain(ks[13], MLA_Q_RANK),
        "w_uq": nrm(ks[14], (L, MLA_Q_RANK, MLA_HEADS * (MLA_NOPE + MLA_ROPE)), MLA_Q_RANK ** -0.5),
        "g_kv": gain(ks[15], MLA_KV_RANK),
        "w_ukv": nrm(ks[16], (L, MLA_KV_RANK, MLA_HEADS * (MLA_NOPE + MLA_V)), MLA_KV_RANK ** -0.5),
        "w_oa": nrm(ks[17], (L, MLA_HEADS * MLA_V, D_MODEL), (MLA_HEADS * MLA_V) ** -0.5),
        "w_ob": nrm(ks[18], (L, FOX_WIDTH, D_MODEL), FOX_WIDTH ** -0.5),
        "w_o": nrm(ks[19], (L, D_MODEL, D_MODEL), D_MODEL ** -0.5),
        "g_ffn": gain(ks[20], D_MODEL),
        "w_up": nrm(ks[21], (L, D_MODEL, 2 * D_FF), D_MODEL ** -0.5),
        "w_conv": nrm(ks[22], (L, CONV_W, 2 * D_FF), CONV_W ** -0.5),
        "b_conv": nrm(ks[23], (L, 2 * D_FF), 0.01),
        "w_down": nrm(ks[24], (L, D_FF, D_MODEL), D_FF ** -0.5),
        "g_ple": gain(ks[25], D_MODEL),
        "w_pg": nrm(ks[26], (L, D_MODEL, D_MODEL), D_MODEL ** -0.5),
        "w_ple": nrm(ks[27], (L, PLE_DIM, D_MODEL), PLE_DIM ** -0.5),
        "g_final": 1.0 + 0.1 * jax.random.normal(ks[28], (D_MODEL,), jnp.float32),
    }


def reference(x_prompt, x_sample, cache_mla_ckv, cache_mla_krope, cache_fox_k, cache_fox_v,
              cache_fox_logf, state_ffn_conv, p_prompt, p_sample, g_mix, w_in, b_f, g_q, w_uq,
              g_kv, w_ukv, w_oa, w_ob, w_o, g_ffn, w_up, w_conv, b_conv, w_down, g_ple, w_pg,
              w_ple, g_final):
    def layer_weights(i):
        return {"g_mix": g_mix[i], "w_in": w_in[i], "b_f": b_f[i], "g_q": g_q[i], "w_uq": w_uq[i],
                "g_kv": g_kv[i], "w_ukv": w_ukv[i], "w_oa": w_oa[i], "w_ob": w_ob[i], "w_o": w_o[i],
                "g_ffn": g_ffn[i], "w_up": w_up[i], "w_conv": w_conv[i], "b_conv": b_conv[i],
                "w_down": w_down[i], "g_ple": g_ple[i], "w_pg": w_pg[i], "w_ple": w_ple[i]}

    h_p, st_p = x_prompt, []
    for i in range(DEPTH):
        h_p, st = layer(h_p, p_prompt[i], None, layer_weights(i))
        st_p.append(st)
    y_prompt = rmsnorm(h_p, g_final)

    h_s, st_s = x_sample, []
    for i in range(DEPTH):
        past = (cache_mla_ckv[i], cache_mla_krope[i], cache_fox_k[i], cache_fox_v[i],
                cache_fox_logf[i], state_ffn_conv[i])
        h_s, st = layer(h_s, p_sample[i], past, layer_weights(i))
        st_s.append(st)
    y_sample = rmsnorm(h_s, g_final)

    def stk(states, j):
        return jnp.stack([s[j] for s in states], axis=0)

    return (y_prompt, y_sample,
            stk(st_p, 0), stk(st_s, 0),
            stk(st_p, 1), stk(st_s, 1),
            stk(st_p, 2), stk(st_s, 2),
            stk(st_p, 3), stk(st_s, 3),
            stk(st_p, 4), stk(st_s, 4),
            stk(st_p, 5), stk(st_s, 5))
```

```cpp
#include <hip/hip_runtime.h>
#include <cstdio>
#include <cstdint>
__device__ __forceinline__ int lane_id_nv() { int l; asm volatile("v_mbcnt_lo_u32_b32 %0, -1, 0\n\tv_mbcnt_hi_u32_b32 %0, -1, %0" : "=v"(l)); return l; }
namespace pg8 {
#define PG8_LAS __attribute__((address_space(3)))
typedef unsigned short bf16_t;
typedef short bf16x8 __attribute__((ext_vector_type(8)));
typedef float f32x4 __attribute__((ext_vector_type(4)));
typedef unsigned u32x4 __attribute__((ext_vector_type(4)));
constexpr int BM = 256, BK = 64, HALF = 128, HTB = HALF * BK * 2  , STAGE_BYTES = 8 * HTB, NXCD = 8, WGM = 8;

__host__ __device__ __forceinline__ int lds_byte(int r, int c) { const int st = (r >> 4) * 2 + (c >> 5), rr = r & 15, cc = c & 31, ob = rr * 64 + cc * 2; return st * 1024 + (ob ^ (((ob >> 9) & 1) << 5)); }
__host__ __device__ __forceinline__ void stage_rc(int b, int& R, int& C) { const int st = b / 1024, sb = b % 1024, swz = sb ^ (((sb >> 9) & 1) << 5); R = (st >> 1) * 16 + swz / 64; C = (st & 1) * 32 + (swz % 64) / 2; }
__host__ __device__ __forceinline__ int perm32(int rho) { const int n = rho >> 4, i = rho & 15; return 8 * (i >> 2) + 4 * n + (i & 3); }

struct Unit { int pm, pn, kb; };
struct Gemm { const bf16_t* A; const bf16_t* Bt; int M, N, K, ld; };

struct StaticOrder {
    int nM, nN, nwg, G, c;
    __host__ __device__ void init(int M, int N, int G_, int c_) { nM = M / BM; nN = N / BM; nwg = nM * nN; G = G_; c = c_; }
    __host__ __device__ bool next(int i, Unit& u) const {
        const long L = (long)i * G + c; if (L >= nwg) return false;
        int wgid = (int)L; { const int q = nwg / NXCD, r = nwg % NXCD, xcd = wgid % NXCD, off = wgid / NXCD; wgid = (xcd < r ? xcd * (q + 1) : r * (q + 1) + (xcd - r) * q) + off; }
        const int nig = WGM * nN, gid = wgid / nig, fm = gid * WGM, gsz = (nM - fm) < WGM ? (nM - fm) : WGM;
        u.pm = fm + ((wgid % nig) % gsz); u.pn = (wgid % nig) / gsz; return true;
    }
    __device__ __forceinline__ void a_ready(const Unit&) const {}
    __device__ __forceinline__ void done(const Unit&) const {}
};
__device__ __forceinline__ unsigned cvt_pk_bf16(float lo, float hi) { unsigned r; asm volatile("v_cvt_pk_bf16_f32 %0, %1, %2" : "=v"(r) : "v"(lo), "v"(hi)); return r; }
template <class Epi, class Sched, bool ALIGN_EPI = false, bool SP2 = false>
__device__ __forceinline__ void gemm_phase(PG8_LAS unsigned char* lds, const Gemm g, const Sched& S, const Epi& E, const int wave_id) {
    int tid_ = wave_id * 64 + lane_id_nv(); asm volatile("" : "+v"(tid_));
    const int tid = tid_, wid = __builtin_amdgcn_readfirstlane(tid >> 6), lane = tid & 63, wr = wid >> 2, wc = wid & 3, fr = lane & 15, fq = lane >> 4;
    const int K = g.K, nt = K / BK, ld = g.ld ? g.ld : g.K;
    unsigned voffA[2], voffB[2];
#pragma unroll
    for (int i = 0; i < 2; ++i) { int R, C; stage_rc(tid * 16 + i * 8192, R, C); const int Rb = Epi::PERM ? ((R & ~31) + perm32(R & 31)) : R;
        voffA[i] = (unsigned)(R * ld + C) * 2u; voffB[i] = (unsigned)(Rb * ld + C) * 2u; }
    const size_t kstep = (size_t)(BK * 2);
    const size_t hstep = (size_t)HALF * ld * 2;
    const size_t tstep = 2 * hstep;
    const unsigned ldsw = (unsigned)wid * 1024u;
    const int aoff = lds_byte(wr * 64 + fr, fq * 8), boff = lds_byte(wc * 32 + fr, fq * 8);
#define PG8_SA(b, h) (((b) * 2 + (h)) * HTB)
#define PG8_SB(b, h) ((4 + (b) * 2 + (h)) * HTB)
#define PG8_STAGE(bufoff, gbase, voff) do { _Pragma("unroll") for (int _i = 0; _i < 2; ++_i) \
        __builtin_amdgcn_global_load_lds((const unsigned*)((const char*)(gbase) + (voff)[_i]), (PG8_LAS unsigned*)(lds + (bufoff) + ldsw + _i * 8192), 16, 0, 0); } while (0)
#define PG8_LDA(dst, b, h) do { _Pragma("unroll") for (int m = 0; m < 4; ++m) _Pragma("unroll") for (int k = 0; k < 2; ++k) dst[m][k] = *(const PG8_LAS bf16x8*)(lds + PG8_SA(b, h) + aoff + m * 2048 + k * 1024); } while (0)
#define PG8_LDB(dst, b, h) do { _Pragma("unroll") for (int n = 0; n < 2; ++n) _Pragma("unroll") for (int k = 0; k < 2; ++k) dst[n][k] = *(const PG8_LAS bf16x8*)(lds + PG8_SB(b, h) + boff + n * 2048 + k * 1024); } while (0)
#define PG8_MMA(ai, bj, At, Bt) do { __builtin_amdgcn_s_setprio(1); _Pragma("unroll") for (int m = 0; m < 4; ++m) _Pragma("unroll") for (int n = 0; n < 2; ++n) _Pragma("unroll") for (int k = 0; k < 2; ++k) \
        acc[ai][bj][m][n] = __builtin_amdgcn_mfma_f32_16x16x32_bf16(Bt[n][k], At[m][k], acc[ai][bj][m][n], 0, 0, 0); __builtin_amdgcn_s_setprio(0); } while (0)
#define PG8_WAIT_V(n) asm volatile("s_waitcnt vmcnt(" #n ")" ::: "memory")
#define PG8_WAIT_L(n) asm volatile("s_waitcnt lgkmcnt(" #n ")" ::: "memory")
#define PG8_BAR __builtin_amdgcn_s_barrier()
#define PG8_SCHED __builtin_amdgcn_sched_barrier(0)
    Unit cur, nxt; int ui = 0;
    if (!S.next(0, cur)) return;
    f32x4 acc[2][2][4][2];
#pragma unroll
    for (int a = 0; a < 2; ++a)
#pragma unroll
        for (int b = 0; b < 2; ++b)
#pragma unroll
            for (int m = 0; m < 4; ++m)
#pragma unroll
                for (int n = 0; n < 2; ++n) acc[a][b][m][n] = (f32x4){0.f, 0.f, 0.f, 0.f};
    bf16x8 At[4][2], B0[2][2], B1[2][2];
    const char* cA = (const char*)g.A + (size_t)cur.pm * tstep + cur.kb; const char* cB = (const char*)g.Bt + (size_t)cur.pn * tstep + cur.kb;
    S.a_ready(cur);
    if constexpr (SP2) {
        PG8_STAGE(PG8_SB(0, 0), cB, voffB); PG8_STAGE(PG8_SB(0, 1), cB + hstep, voffB); PG8_STAGE(PG8_SA(0, 0), cA, voffA); PG8_STAGE(PG8_SA(0, 1), cA + hstep, voffA);
        if (wr == 1) PG8_BAR;
        PG8_WAIT_V(2); PG8_BAR;
        PG8_STAGE(PG8_SB(1, 0), cB + kstep, voffB); PG8_STAGE(PG8_SA(1, 0), cA + kstep, voffA); PG8_STAGE(PG8_SB(1, 1), cB + hstep + kstep, voffB);
        PG8_WAIT_V(6); PG8_BAR;
    } else {
        PG8_STAGE(PG8_SB(0, 0), cB, voffB); PG8_STAGE(PG8_SA(0, 0), cA, voffA); PG8_STAGE(PG8_SB(0, 1), cB + hstep, voffB); PG8_STAGE(PG8_SA(0, 1), cA + hstep, voffA);
        if (wr == 1) PG8_BAR;
        PG8_WAIT_V(4); PG8_BAR;
        PG8_STAGE(PG8_SB(1, 0), cB + kstep, voffB); PG8_STAGE(PG8_SA(1, 0), cA + kstep, voffA); PG8_STAGE(PG8_SB(1, 1), cB + hstep + kstep, voffB);
        PG8_WAIT_V(6); PG8_BAR;
    }
    for (;;) {
        const bool has_next = S.next(ui + 1, nxt);
        const char* nA = has_next ? (const char*)g.A + (size_t)nxt.pm * tstep + nxt.kb : cA; const char* nB = has_next ? (const char*)g.Bt + (size_t)nxt.pn * tstep + nxt.kb : cB;
        for (int t = 0; t < nt; t += 2) {
            const bool last = (t == nt - 2);
            const char* a1 = cA + (size_t)(t + 1) * kstep;
            const char* a2 = last ? nA : cA + (size_t)(t + 2) * kstep; const char* b2 = last ? nB : cB + (size_t)(t + 2) * kstep;
            const char* a3 = a2 + kstep; const char* b3 = b2 + kstep;
            if (last && has_next) S.a_ready(nxt);
            if constexpr (SP2) {
            PG8_LDB(B0, 0, 0); PG8_LDB(B1, 0, 1); PG8_SCHED; PG8_LDA(At, 0, 0); PG8_STAGE(PG8_SA(1, 1), a1 + hstep, voffA);
            PG8_WAIT_V(8); PG8_WAIT_L(0); PG8_BAR; PG8_MMA(0, 0, At, B0); PG8_MMA(0, 1, At, B1); PG8_BAR; PG8_SCHED;
            PG8_LDA(At, 0, 1); PG8_STAGE(PG8_SB(0, 0), b2, voffB); PG8_STAGE(PG8_SB(0, 1), b2 + hstep, voffB); PG8_STAGE(PG8_SA(0, 0), a2, voffA);
            PG8_WAIT_V(8); PG8_WAIT_L(0); PG8_BAR; PG8_MMA(1, 0, At, B0); PG8_MMA(1, 1, At, B1); PG8_BAR; PG8_SCHED;
            PG8_LDB(B0, 1, 0); PG8_LDB(B1, 1, 1); PG8_SCHED; PG8_LDA(At, 1, 0); PG8_STAGE(PG8_SA(0, 1), a2 + hstep, voffA);
            PG8_WAIT_V(8); PG8_WAIT_L(0); PG8_BAR; PG8_MMA(0, 0, At, B0); PG8_MMA(0, 1, At, B1); PG8_BAR; PG8_SCHED;
            PG8_LDA(At, 1, 1); PG8_STAGE(PG8_SB(1, 0), b3, voffB); PG8_STAGE(PG8_SB(1, 1), b3 + hstep, voffB); PG8_STAGE(PG8_SA(1, 0), a3, voffA);
            PG8_WAIT_V(8); PG8_WAIT_L(0); PG8_BAR; PG8_MMA(1, 0, At, B0); PG8_MMA(1, 1, At, B1); PG8_BAR; PG8_SCHED;
            } else {
            PG8_LDB(B0, 0, 0); PG8_SCHED; PG8_LDA(At, 0, 0); PG8_STAGE(PG8_SA(1, 1), a1 + hstep, voffA);
            PG8_WAIT_L(8); PG8_BAR; PG8_WAIT_L(0); PG8_MMA(0, 0, At, B0); PG8_BAR; PG8_SCHED;
            PG8_LDB(B1, 0, 1); PG8_STAGE(PG8_SB(0, 0), b2, voffB);
            PG8_BAR; PG8_WAIT_L(0); PG8_MMA(0, 1, At, B1); PG8_BAR;
            PG8_LDA(At, 0, 1); PG8_STAGE(PG8_SA(0, 0), a2, voffA);
            PG8_BAR; PG8_WAIT_L(0); PG8_MMA(1, 0, At, B0); PG8_BAR; PG8_SCHED;
            PG8_STAGE(PG8_SB(0, 1), b2 + hstep, voffB);
            PG8_WAIT_V(6); PG8_BAR; PG8_MMA(1, 1, At, B1); PG8_BAR;
            PG8_LDB(B0, 1, 0); PG8_SCHED; PG8_LDA(At, 1, 0); PG8_STAGE(PG8_SA(0, 1), a2 + hstep, voffA);
            PG8_WAIT_L(8); PG8_BAR; PG8_WAIT_L(0); PG8_MMA(0, 0, At, B0); PG8_BAR; PG8_SCHED;
            PG8_LDB(B1, 1, 1); PG8_STAGE(PG8_SB(1, 0), b3, voffB);
            PG8_BAR; PG8_WAIT_L(0); PG8_MMA(0, 1, At, B1); PG8_BAR;
            PG8_LDA(At, 1, 1); PG8_STAGE(PG8_SA(1, 0), a3, voffA);
            PG8_BAR; PG8_WAIT_L(0); PG8_MMA(1, 0, At, B0); PG8_BAR; PG8_SCHED;
            PG8_STAGE(PG8_SB(1, 1), b3 + hstep, voffB);
            PG8_WAIT_V(6); PG8_BAR; PG8_MMA(1, 1, At, B1); PG8_BAR;
            }
        }
        if constexpr (ALIGN_EPI) { if (wr == 0) PG8_BAR; }
        if constexpr (!Epi::AFTER_DRAIN) { E(acc, cur, wr, wc, fr, fq); S.done(cur); }
        if (!has_next) break;
#pragma unroll
        for (int a = 0; a < 2; ++a)
#pragma unroll
            for (int b = 0; b < 2; ++b)
#pragma unroll
                for (int m = 0; m < 4; ++m)
#pragma unroll
                    for (int n = 0; n < 2; ++n) acc[a][b][m][n] = (f32x4){0.f, 0.f, 0.f, 0.f};
        cur = nxt; cA = nA; cB = nB; ++ui;
        if constexpr (ALIGN_EPI) { if (wr == 1) PG8_BAR; }
    }
    PG8_WAIT_V(0);
    if constexpr (!ALIGN_EPI) { if (wr == 0) PG8_BAR; }
    PG8_BAR;
    if constexpr (Epi::AFTER_DRAIN) { E.fused(acc, cur, wr, wc, fr, fq, lds, wid, lane); S.done(cur); }
#undef PG8_SA
#undef PG8_SB
#undef PG8_STAGE
#undef PG8_LDA
#undef PG8_LDB
#undef PG8_MMA
#undef PG8_WAIT_V
#undef PG8_WAIT_L
#undef PG8_BAR
#undef PG8_SCHED
}
}

constexpr int NWAVES = 8;
constexpr int DM = 2048, MP = 32768, MS = 512, MT = MP + MS;
constexpr int TP = 4096, NBP = 8, NBS = 16, TS = 32, PAST = 2048, SKV = PAST + TS;
constexpr int RKV = MP + NBS * SKV, RKV_PAD = RKV + 64;
constexpr int QR = 512, KVR = 512, ROPE = 64, NH = 8, HD = 128, FW = 1024, DFF = 5632, DFF2 = 11264, PLE = 256;
constexpr int INW = 8264, NIN = 8448;
constexpr int NQ = 1536, NKV = 2048, SCUM = 2112;
constexpr float EPS = 1e-6f, LOG2E = 1.4426950408889634f;
constexpr float MLA_C2 = 0.07216878364870322f * LOG2E, FOX_C2 = 0.08838834764831845f * LOG2E;
constexpr int KSPLIT = 11;
constexpr int CHUNK_TILES = 128, NCHUNK = 2;
constexpr int NPHASE = 9 + 3 * 3 + 3;

constexpr size_t O_Y = 0, O_CKV = (size_t)MT * DM, O_KR = O_CKV + (size_t)MT * KVR, O_FK = O_KR + (size_t)MT * ROPE, O_FV = O_FK + (size_t)MT * FW,
                 O_LF = O_FV + (size_t)MT * FW, O_CVP = O_LF + (size_t)MT * NH, O_CVS = O_CVP + (size_t)NBP * 2 * DFF2, O_END = O_CVS + (size_t)NBS * 2 * DFF2;
static_assert(O_END == 156291072ull, "d_out size");

constexpr size_t MiB = 1u << 20;
constexpr size_t WS_CTL = 0, CTL_ZERO_BYTES = 1 * MiB;
constexpr size_t WS_ROPE = 1 * MiB, WS_NCUMP = 2 * MiB, WS_NCUMS = 3 * MiB, WS_RSS = 5 * MiB, WS_PE = 6 * MiB, WS_KR = 23 * MiB;
constexpr size_t WS_WIN = 32 * MiB, WS_WUQ = 65 * MiB, WS_WUKV = WS_WUQ + 3 * MiB / 2, WS_WOA = WS_WUKV + 2 * MiB, WS_WOB = WS_WOA + 4 * MiB, WS_WO = WS_WOB + 4 * MiB,
                 WS_WUP = WS_WO + 8 * MiB, WS_WDN = WS_WUP + 44 * MiB, WS_WPG = WS_WDN + 22 * MiB, WS_WPLE = WS_WPG + 8 * MiB;
constexpr size_t WS_D = 160 * MiB;
static_assert(WS_WPLE + 1 * MiB <= WS_D, "weights fit");
constexpr size_t WS_FK = WS_D, WS_FV = WS_D + 130 * MiB, WS_FQ = WS_D + 260 * MiB, WS_CKV = WS_D + 325 * MiB, WS_CQN = WS_D + 390 * MiB, WS_QM = WS_D + 423 * MiB,
                 WS_KM = WS_D + 521 * MiB, WS_VM = WS_D + 651 * MiB, WS_A0 = WS_D + 521 * MiB, WS_CQR = WS_D + 651 * MiB, WS_OA = WS_D + 325 * MiB, WS_OB = WS_D + 781 * MiB,
                 WS_A0B = WS_D, WS_SGA = WS_D + 130 * MiB, WS_SGB = WS_D + 650 * MiB, WS_SGS = WS_D + 846 * MiB, WS_SLAB = WS_D + 528 * MiB, WS_UH = WS_D + 482 * MiB, WS_MG = WS_D + 455 * MiB, WS_HB = WS_D + 585 * MiB, WS_U = WS_D + 572 * MiB, WS_ACT = WS_D + 130 * MiB, WS_HB2 = WS_D + 715 * MiB, WS_PLEO = WS_D, WS_END = 1024 * MiB;
static_assert((size_t)RKV_PAD * 1024 * 2 <= 130 * MiB && (size_t)MT * NQ * 2 <= 98 * MiB && WS_OB + 65 * MiB <= WS_END && WS_HB2 + 130 * MiB <= WS_END, "d_ws map");
constexpr int CW_QA = 64, CW_QB = 128, CW_QKMAX = 320;
constexpr int CW_BAR = 4096;
constexpr int RING_OFF = 0, RING_BYTES = 131072, LDSCTL_OFF = RING_BYTES, MISC_OFF = LDSCTL_OFF + 320, HALO_OFF = LDSCTL_OFF + 2048, LDS_BYTES = 147456;

#define GAS __attribute__((address_space(1)))
#define LAS __attribute__((address_space(3)))
typedef unsigned short bf16;
typedef unsigned v4u __attribute__((ext_vector_type(4)));
typedef unsigned v2u __attribute__((ext_vector_type(2)));
typedef float f32x4 __attribute__((ext_vector_type(4)));
typedef float f32x16 __attribute__((ext_vector_type(16)));
typedef short bf16x8 __attribute__((ext_vector_type(8)));
typedef short s16x4 __attribute__((ext_vector_type(4)));
typedef GAS unsigned gu32;
#define RLX_AGENT __ATOMIC_RELAXED, __HIP_MEMORY_SCOPE_AGENT
#define LDS_WAIT() asm volatile("s_waitcnt lgkmcnt(0)" ::: "memory")
#define VM_WAIT() asm volatile("s_waitcnt vmcnt(0)" ::: "memory")
__device__ __forceinline__ unsigned f2bf(float f) { unsigned u = __builtin_bit_cast(unsigned, f); return (u + 0x7fffu + ((u >> 16) & 1u)) >> 16; }
typedef float f32x2_t __attribute__((ext_vector_type(2)));
typedef __bf16 bf16x2_t __attribute__((ext_vector_type(2)));
__device__ __forceinline__ unsigned pk2(float lo, float hi) { f32x2_t v = {lo, hi}; bf16x2_t b = __builtin_convertvector(v, bf16x2_t); return __builtin_bit_cast(unsigned, b); }
__device__ __forceinline__ float bf2f(unsigned short b) { return __builtin_bit_cast(float, (unsigned)b << 16); }
__device__ __forceinline__ v4u pack8(f32x4 a, f32x4 b) { v4u w; w.x = pk2(a[0], a[1]); w.y = pk2(a[2], a[3]); w.z = pk2(b[0], b[1]); w.w = pk2(b[2], b[3]); return w; }
__device__ __forceinline__ v2u pack4(f32x4 a) { v2u w; w.x = pk2(a[0], a[1]); w.y = pk2(a[2], a[3]); return w; }
__device__ __forceinline__ void unpack8(v4u w, f32x4& a, f32x4& b) {
    a[0] = __builtin_bit_cast(float, w.x << 16); a[1] = __builtin_bit_cast(float, w.x & 0xffff0000u); a[2] = __builtin_bit_cast(float, w.y << 16); a[3] = __builtin_bit_cast(float, w.y & 0xffff0000u);
    b[0] = __builtin_bit_cast(float, w.z << 16); b[1] = __builtin_bit_cast(float, w.z & 0xffff0000u); b[2] = __builtin_bit_cast(float, w.w << 16); b[3] = __builtin_bit_cast(float, w.w & 0xffff0000u); }
__device__ __forceinline__ float sigmoidf_(float x) { return __builtin_amdgcn_rcpf(1.f + __builtin_amdgcn_exp2f(-x * LOG2E)); }
__device__ __forceinline__ f32x4 sigmoid4(f32x4 v) { f32x4 o; o[0] = sigmoidf_(v[0]); o[1] = sigmoidf_(v[1]); o[2] = sigmoidf_(v[2]); o[3] = sigmoidf_(v[3]); return o; }
__device__ __forceinline__ int kvrow_of(int row) { if (row < MP) return row; const int s = row - MP; return MP + (s >> 5) * SKV + PAST + (s & 31); }
__device__ __forceinline__ int pos_of(int row) { return row < MP ? (row & (TP - 1)) : PAST + ((row - MP) & 31); }
__device__ __forceinline__ float wave_sum(float v) {
#pragma unroll
    for (int o = 1; o < 64; o <<= 1) v += __shfl_xor(v, o);
    return v;
}
#define XB_TMO      128
#define XB_XCNT(j)  (256  + 64 * (j))
#define XB_XSUB(j)  (1280 + 64 * (j))
#define XB_XGEN(j)  (2304 + 64 * (j))
#define XB_TOP      3328
#define XB_TOPGEN   3392
#define XCD_BAR_WORDS 3456
#define XB_SPIN_CAP (1u << 18)

__device__ __forceinline__ unsigned xb_ld(unsigned* p)              { return __hip_atomic_load(p, __ATOMIC_RELAXED, __HIP_MEMORY_SCOPE_AGENT); }
__device__ __forceinline__ unsigned xb_add(unsigned* p, unsigned v) { return __hip_atomic_fetch_add(p, v, __ATOMIC_RELAXED, __HIP_MEMORY_SCOPE_AGENT); }
__device__ __forceinline__ unsigned xb_xcc_id() { return (unsigned)__builtin_amdgcn_s_getreg((3 << 11) | 20) & 0xFu; }
#define XB_SPIN(cond, bar) do { unsigned _sp = 0; while (cond) { __builtin_amdgcn_s_sleep(1); \
    if ((++_sp & 255u) == 0u) { if (xb_ld(&(bar)[XB_TMO])) break; if (_sp > XB_SPIN_CAP) { atomicAdd(&(bar)[XB_TMO], 1u); break; } } } } while (0)

struct XcdBarrier {
    unsigned* bar; unsigned x; unsigned wv;
    volatile LAS unsigned* st;
};

__device__ __forceinline__ XcdBarrier xcd_barrier_post(unsigned* bar, volatile LAS unsigned* st) {
    XcdBarrier b; b.bar = bar; b.x = xb_xcc_id(); b.st = st; b.wv = (unsigned)__builtin_amdgcn_readfirstlane(threadIdx.x >> 6);
    if (threadIdx.x == 0) (void)xb_add(&bar[XB_XCNT(b.x)], 1u);
    return b;
}
__device__ __forceinline__ void xcd_barrier_complete(unsigned* bar, unsigned x, unsigned& nloc, unsigned& nx) {
    const unsigned G = gridDim.x * gridDim.y * gridDim.z;
    unsigned sum, cnt, mine, sp = 0u;
    for (;;) {
        sum = 0u; cnt = 0u; mine = 0u;
#pragma unroll
        for (unsigned j = 0; j < 16; ++j) { const unsigned c = xb_ld(&bar[XB_XCNT(j)]); sum += c; cnt += (c > 0u) ? 1u : 0u; mine = (j == x) ? c : mine; }
        if (sum == G) break;
        __builtin_amdgcn_s_sleep(1);
        if ((++sp & 255u) == 0u) { if (xb_ld(&bar[XB_TMO])) break; if (sp > XB_SPIN_CAP) { atomicAdd(&bar[XB_TMO], 1u); break; } }
    }
    nloc = mine > 0u ? mine : 1u; nx = cnt > 0u ? cnt : 1u;
}

__device__ __forceinline__ void xcd_barrier(const XcdBarrier& b) {
    asm volatile("s_waitcnt vmcnt(0)" ::: "memory");
    __syncthreads();
    if (b.wv == 0u && (unsigned)lane_id_nv() == 0u) {
        gu32* barg = (gu32*)b.bar; asm volatile("" : "+s"(barg)); unsigned* bar = (unsigned*)barg;
        __builtin_amdgcn_s_waitcnt(0);
        unsigned nloc = b.st[0], nx = b.st[1];
        if (nloc == 0u) { xcd_barrier_complete(bar, b.x, nloc, nx); b.st[0] = nloc; b.st[1] = nx; }
        const unsigned old = xb_add(&bar[XB_XSUB(b.x)], 1u);
        const unsigned gen = old / nloc;
        if (old + 1u == (gen + 1u) * nloc) {
            __builtin_amdgcn_fence(__ATOMIC_RELEASE, "agent");
            asm volatile("s_waitcnt vmcnt(0)" ::: "memory");
            const unsigned og = xb_add(&bar[XB_TOP], 1u);
            const unsigned tg = og / nx;
            if (og + 1u == (tg + 1u) * nx) xb_add(&bar[XB_TOPGEN], 1u);
            else XB_SPIN(xb_ld(&bar[XB_TOPGEN]) == tg, bar);
            __builtin_amdgcn_fence(__ATOMIC_ACQUIRE, "agent");
            xb_add(&bar[XB_XGEN(b.x)], 1u);
            asm volatile("s_waitcnt vmcnt(0)" ::: "memory");
        } else {
            XB_SPIN(xb_ld(&bar[XB_XGEN(b.x)]) == gen, bar);
            __builtin_amdgcn_fence(__ATOMIC_ACQUIRE, "agent");
            asm volatile("s_waitcnt vmcnt(0)" ::: "memory");
        }
    }
    __syncthreads();
}

struct TileOrder {
    pg8::StaticOrder s; int pm0;
    __device__ __forceinline__ void init(int nM, int nN, int G, int c, int pm0_) { s.init(nM * 256, nN * 256, G, c); pm0 = pm0_; }
    __device__ __forceinline__ bool next(int i, pg8::Unit& u) const { if (!s.next(i, u)) return false; u.pm += pm0; u.kb = 0; return true; }
    __device__ __forceinline__ void a_ready(const pg8::Unit&) const {}
    __device__ __forceinline__ void done(const pg8::Unit&) const {}
};

struct P1Order {
    TileOrder t; int G, c;
    __device__ __forceinline__ void init(int G_, int c_) { t.init(MT / 256, 17, G_, c_, 0); G = G_; c = c_; }
    __device__ __forceinline__ bool next(int i, pg8::Unit& u) const { if (t.next(i, u)) return true; const int e = i * G + c - (MT / 256) * 17; if (e < 0 || e >= 32) return false; u.pm = 128 + (e & 1); u.pn = 17 + (e >> 1); u.kb = 0; return true; }
    __device__ __forceinline__ void a_ready(const pg8::Unit&) const {}
    __device__ __forceinline__ void done(const pg8::Unit&) const {}
};
struct SplitKOrder {
    int G, c;
    __device__ __forceinline__ void init(int G_, int c_) { G = G_; c = c_; }
    __device__ __forceinline__ bool next(int i, pg8::Unit& u) const { const int L = i * G + c; if (L >= 16 * KSPLIT) return false; u.pm = 128 + (L & 1); u.pn = (L >> 1) & 7; u.kb = (L >> 4) * (DFF / KSPLIT) * 2; return true; }
    __device__ __forceinline__ void a_ready(const pg8::Unit&) const {}
    __device__ __forceinline__ void done(const pg8::Unit&) const {}
};

#define EPI_HDR static constexpr bool PERM = true, AFTER_DRAIN = false;
#define EPI_ARGS const f32x4 (&acc)[2][2][4][2], const pg8::Unit& u, int wr, int wc, int fr, int fq
#define EPI_ROWS _Pragma("unroll") for (int ai = 0; ai < 2; ++ai) _Pragma("unroll") for (int m = 0; m < 4; ++m)

struct EpiIn {
    EPI_HDR
    float* out; float* cq_raw; bf16* kr_all; bf16* fq_; bf16* fk_all; bf16* fv_all; bf16* sga; bf16* sgb; const float* ropec; const float* ropes; const float* b_f;
    __device__ __forceinline__ void operator()(EPI_ARGS) const {
        const int pn = u.pn, rowb = u.pm * 256 + wr * 64 + fr, cl = wc * 32 + 8 * fq;
        if (pn < 4) {
            float* base = pn < 2 ? cq_raw : out + O_CKV; const int c0 = (pn & 1) * 256 + cl;
            EPI_ROWS { float* p = base + (size_t)(rowb + ai * 128 + m * 16) * 512 + c0;
#pragma unroll
                for (int bj = 0; bj < 2; ++bj) { *(f32x4*)(p + bj * 128) = acc[ai][bj][m][0]; *(f32x4*)(p + bj * 128 + 4) = acc[ai][bj][m][1]; } }
        } else if (pn == 4) {
            if (wc < 2) {
                const int i0 = cl >> 1;
                EPI_ROWS { const int row = rowb + ai * 128 + m * 16, pos = pos_of(row), kvr = kvrow_of(row);
                    const f32x4 c4 = *(const f32x4*)(ropec + pos * 32 + i0), s4 = *(const f32x4*)(ropes + pos * 32 + i0);
                    const f32x4 v0 = acc[ai][0][m][0], v1 = acc[ai][0][m][1];
                    f32x4 o1, o2;
                    o1[0] = v0[0] * c4[0] - v0[1] * s4[0]; o2[0] = v0[1] * c4[0] + v0[0] * s4[0];
                    o1[1] = v0[2] * c4[1] - v0[3] * s4[1]; o2[1] = v0[3] * c4[1] + v0[2] * s4[1];
                    o1[2] = v1[0] * c4[2] - v1[1] * s4[2]; o2[2] = v1[1] * c4[2] + v1[0] * s4[2];
                    o1[3] = v1[2] * c4[3] - v1[3] * s4[3]; o2[3] = v1[3] * c4[3] + v1[2] * s4[3];
                    float* po = out + O_KR + (size_t)row * 64 + i0; *(f32x4*)po = o1; *(f32x4*)(po + 32) = o2;
                    bf16* pb = kr_all + (size_t)kvr * 64 + i0; *(v2u*)pb = pack4(o1); *(v2u*)(pb + 32) = pack4(o2); }
            } else if (wc == 2 && fq == 0) {
                const f32x4 b0 = *(const f32x4*)b_f, b1 = *(const f32x4*)(b_f + 4);
                EPI_ROWS { const int row = rowb + ai * 128 + m * 16; f32x4 x0 = acc[ai][0][m][0] + b0, x1 = acc[ai][0][m][1] + b1, l0, l1;
#pragma unroll
                    for (int k = 0; k < 4; ++k) { l0[k] = fminf(x0[k], 0.f) - log1pf(expf(-fabsf(x0[k]))); l1[k] = fminf(x1[k], 0.f) - log1pf(expf(-fabsf(x1[k]))); }
                    float* po = out + O_LF + (size_t)row * 8; *(f32x4*)po = l0; *(f32x4*)(po + 4) = l1; }
            }
        } else if (pn < 9) {
            const int c0 = (pn - 5) * 256 + cl;
            EPI_ROWS { bf16* p = fq_ + (size_t)(rowb + ai * 128 + m * 16) * FW + c0;
#pragma unroll
                for (int bj = 0; bj < 2; ++bj) *(v4u*)(p + bj * 128) = pack8(acc[ai][bj][m][0] * FOX_C2, acc[ai][bj][m][1] * FOX_C2); }
        } else if (pn >= 17) {
            const int t = pn - 17, c0 = (t & 7) * 256 + cl; bf16* gb = t < 8 ? sga : sgb;
            EPI_ROWS { bf16* p = gb + (size_t)(rowb + ai * 128 + m * 16) * DM + c0;
#pragma unroll
                for (int bj = 0; bj < 2; ++bj) *(v4u*)(p + bj * 128) = pack8(sigmoid4(acc[ai][bj][m][0]), sigmoid4(acc[ai][bj][m][1])); }
        } else {
            const bool isk = pn < 13; const int c0 = (pn - (isk ? 9 : 13)) * 256 + cl; float* ob = out + (isk ? O_FK : O_FV); bf16* bb = isk ? fk_all : fv_all;
            EPI_ROWS { const int row = rowb + ai * 128 + m * 16, kvr = kvrow_of(row); float* po = ob + (size_t)row * FW + c0; bf16* pb = bb + (size_t)kvr * FW + c0;
#pragma unroll
                for (int bj = 0; bj < 2; ++bj) { *(f32x4*)(po + bj * 128) = acc[ai][bj][m][0]; *(f32x4*)(po + bj * 128 + 4) = acc[ai][bj][m][1]; *(v4u*)(pb + bj * 128) = pack8(acc[ai][bj][m][0], acc[ai][bj][m][1]); } }
        }
    }
};
struct EpiSig {
    EPI_HDR
    bf16* sga; bf16* sgb;
    __device__ __forceinline__ void operator()(EPI_ARGS) const {
        const int pn = u.pn, rowb = u.pm * 256 + wr * 64 + fr, c0 = (pn & 7) * 256 + wc * 32 + 8 * fq; bf16* gb = pn < 8 ? sga : sgb;
        EPI_ROWS { bf16* p = gb + (size_t)(rowb + ai * 128 + m * 16) * DM + c0;
#pragma unroll
            for (int bj = 0; bj < 2; ++bj) *(v4u*)(p + bj * 128) = pack8(sigmoid4(acc[ai][bj][m][0]), sigmoid4(acc[ai][bj][m][1])); }
    }
};
struct EpiQ {
    EPI_HDR
    bf16* Qm; const float* ropec; const float* ropes;
    __device__ __forceinline__ void operator()(EPI_ARGS) const {
        const int pn = u.pn, rowb = u.pm * 256 + wr * 64 + fr, cl = wc * 32 + 8 * fq;
        if (pn < 4) {
            EPI_ROWS { bf16* p = Qm + (size_t)(rowb + ai * 128 + m * 16) * NQ;
#pragma unroll
                for (int bj = 0; bj < 2; ++bj) { const int c = pn * 256 + bj * 128 + cl, h = c >> 7, d = c & 127;
                    *(v4u*)(p + h * 192 + d) = pack8(acc[ai][bj][m][0] * MLA_C2, acc[ai][bj][m][1] * MLA_C2); } }
        } else {
            EPI_ROWS { const int row = rowb + ai * 128 + m * 16, pos = pos_of(row); bf16* p = Qm + (size_t)row * NQ;
#pragma unroll
                for (int bj = 0; bj < 2; ++bj) { const int c = (pn - 4) * 256 + bj * 128 + cl, h = c >> 6, i0 = (c & 63) >> 1;
                    const f32x4 c4 = *(const f32x4*)(ropec + pos * 32 + i0) * MLA_C2, s4 = *(const f32x4*)(ropes + pos * 32 + i0) * MLA_C2;
                    const f32x4 v0 = acc[ai][bj][m][0], v1 = acc[ai][bj][m][1];
                    f32x4 o1, o2;
                    o1[0] = v0[0] * c4[0] - v0[1] * s4[0]; o2[0] = v0[1] * c4[0] + v0[0] * s4[0];
                    o1[1] = v0[2] * c4[1] - v0[3] * s4[1]; o2[1] = v0[3] * c4[1] + v0[2] * s4[1];
                    o1[2] = v1[0] * c4[2] - v1[1] * s4[2]; o2[2] = v1[1] * c4[2] + v1[0] * s4[2];
                    o1[3] = v1[2] * c4[3] - v1[3] * s4[3]; o2[3] = v1[3] * c4[3] + v1[2] * s4[3];
                    bf16* pb = p + h * 192 + 128 + i0; *(v2u*)pb = pack4(o1); *(v2u*)(pb + 32) = pack4(o2); } }
        }
    }
};
struct EpiKV {
    EPI_HDR
    bf16* Km; bf16* Vm;
    __device__ __forceinline__ void operator()(EPI_ARGS) const {
        const int rowb = u.pm * 256 + wr * 64 + fr, c0 = u.pn * 128 + wc * 32 + 8 * fq;
        EPI_ROWS { const size_t off = (size_t)(rowb + ai * 128 + m * 16) * 1024 + c0;
            *(v4u*)(Km + off) = pack8(acc[ai][0][m][0], acc[ai][0][m][1]); *(v4u*)(Vm + off) = pack8(acc[ai][1][m][0], acc[ai][1][m][1]); }
    }
};
template <bool SECOND> struct EpiGate {
    EPI_HDR
    const bf16* g; const bf16* gS; bf16* mg;
    __device__ __forceinline__ void operator()(EPI_ARGS) const {
        const int rowb = u.pm * 256 + wr * 64 + fr, c0 = u.pn * 256 + wc * 32 + 8 * fq;
        const bf16* gq = u.pm >= MP / 256 ? gS - (size_t)MP * DM : g;
#pragma unroll
        for (int ai = 0; ai < 2; ++ai) {
            v4u gv[4][2], pv[4][2];
#pragma unroll
            for (int m = 0; m < 4; ++m) { const size_t off = (size_t)(rowb + ai * 128 + m * 16) * DM + c0;
#pragma unroll
                for (int bj = 0; bj < 2; ++bj) { gv[m][bj] = *(const v4u*)(gq + off + bj * 128); if (SECOND) pv[m][bj] = *(const v4u*)(mg + off + bj * 128); } }
            asm volatile("" ::: "memory");
#pragma unroll
            for (int m = 0; m < 4; ++m) { const size_t off = (size_t)(rowb + ai * 128 + m * 16) * DM + c0;
#pragma unroll
                for (int bj = 0; bj < 2; ++bj) { f32x4 g0, g1; unpack8(gv[m][bj], g0, g1);
#if defined(DBG_NOGATE)
                    g0 = (f32x4){1.f, 1.f, 1.f, 1.f}; g1 = g0;
#endif
                    f32x4 r0 = g0 * acc[ai][bj][m][0], r1 = g1 * acc[ai][bj][m][1];
                    if (SECOND) { f32x4 p0, p1; unpack8(pv[m][bj], p0, p1); r0 += p0; r1 += p1; }
                    *(v4u*)(mg + off + bj * 128) = pack8(r0, r1); } }
        }
    }
};
template <int MODE> struct EpiRes {
    EPI_HDR
    const float* xp; const float* xs; float* h; bf16* hb; float* rss; const float* rss_in; const bf16* ple;
    __device__ __forceinline__ void operator()(EPI_ARGS) const {
        const int rowb = u.pm * 256 + wr * 64 + fr, c0 = u.pn * 256 + wc * 32 + 8 * fq;
        constexpr int MB = MODE == 2 ? 2 : 4;
#pragma unroll
        for (int ai = 0; ai < 2; ++ai)
#pragma unroll
        for (int mb = 0; mb < 4; mb += MB) {
            f32x4 sv[MB][2][2]; v4u pl[MB][2]; float rsv[MB];
#pragma unroll
            for (int mi = 0; mi < MB; ++mi) { const int m = mb + mi, row = rowb + ai * 128 + m * 16; const size_t off = (size_t)row * DM + c0;
                const float* src = MODE == 0 ? (row < MP ? xp + off : xs + (off - (size_t)MP * DM)) : h + off;
                rsv[mi] = MODE == 2 ? rss_in[row] : 0.f;
#pragma unroll
                for (int bj = 0; bj < 2; ++bj) { sv[mi][bj][0] = *(const f32x4*)(src + bj * 128); sv[mi][bj][1] = *(const f32x4*)(src + bj * 128 + 4); if (MODE == 2) pl[mi][bj] = *(const v4u*)(ple + off + bj * 128); } }
            asm volatile("" ::: "memory");
#pragma unroll
            for (int mi = 0; mi < MB; ++mi) { const int m = mb + mi, row = rowb + ai * 128 + m * 16; const size_t off = (size_t)row * DM + c0;
                float rs = 1.f; if (MODE == 2) rs = __builtin_amdgcn_rsqf(rsv[mi] * (1.f / DM) + EPS);
                float ss = 0.f;
#pragma unroll
                for (int bj = 0; bj < 2; ++bj) { f32x4 a0 = acc[ai][bj][m][0], a1 = acc[ai][bj][m][1];
                    if (MODE == 2) { f32x4 p0, p1; unpack8(pl[mi][bj], p0, p1); a0 = sigmoid4(a0 * rs) * p0; a1 = sigmoid4(a1 * rs) * p1; }
                    const f32x4 r0 = sv[mi][bj][0] + a0, r1 = sv[mi][bj][1] + a1;
                    *(f32x4*)(h + off + bj * 128) = r0; *(f32x4*)(h + off + bj * 128 + 4) = r1;
                    if (MODE != 2) *(v4u*)(hb + off + bj * 128) = pack8(r0, r1);
                    ss += (r0[0] * r0[0] + r0[1] * r0[1]) + (r0[2] * r0[2] + r0[3] * r0[3]) + (r1[0] * r1[0] + r1[1] * r1[1]) + (r1[2] * r1[2] + r1[3] * r1[3]); }
                ss += __shfl_xor(ss, 16); ss += __shfl_xor(ss, 32);
                if (fq == 0) unsafeAtomicAdd(rss + row, ss); }
        }
    }
};
struct EpiUp {
    EPI_HDR
    bf16* U; float* out; const float* rss1; int row0;
    __device__ __forceinline__ void operator()(EPI_ARGS) const {
        const int rowb = u.pm * 256 + wr * 64 + fr, c0 = u.pn * 256 + wc * 32 + 8 * fq;
        EPI_ROWS { const int row = rowb + ai * 128 + m * 16; const float rs = __builtin_amdgcn_rsqf(rss1[row] * (1.f / DM) + EPS);
            bf16* p = U + (size_t)(row - row0) * DFF2 + c0;
            int cs = -1;
            if (row < MP) { const int t = row & (TP - 1); if (t >= TP - 2) cs = (row >> 12) * 2 + (t - (TP - 2)); }
            else { const int s = row - MP, t = s & 31; if (t >= TS - 2) cs = NBP * 2 + (s >> 5) * 2 + (t - (TS - 2)); }
#pragma unroll
            for (int bj = 0; bj < 2; ++bj) { const f32x4 r0 = acc[ai][bj][m][0] * rs, r1 = acc[ai][bj][m][1] * rs;
                *(v4u*)(p + bj * 128) = pack8(r0, r1);
                if (cs >= 0) { float* po = out + O_CVP + (size_t)cs * DFF2 + bj * DFF + u.pn * 128 + wc * 32 + 8 * fq; *(f32x4*)po = r0; *(f32x4*)(po + 4) = r1; } } }
    }
};
struct EpiUpAct {
    EPI_HDR
    bf16* act; float* out; const float* rss1; const float* wconv; const float* bconv; float* Uh; LAS unsigned* halo; int row0;
    __device__ __forceinline__ void operator()(const f32x4 (&acc)[2][2][4][2], const pg8::Unit& u, int wr, int wc, int fr_in, int fq_in) const {
        (void)fr_in; (void)fq_in;
        int ln = lane_id_nv(); asm volatile("" : "+v"(ln));
        const int fr = ln & 15, fq = ln >> 4;
        const int pn = u.pn, pm = u.pm, rowb = pm * 256 + wr * 64 + fr, cl = wc * 32 + 8 * fq;
        const bool bstart = (pm & 15) == 0;
        unsigned P[2][2][4][2][2];
#pragma unroll
        for (int ai = 0; ai < 2; ++ai)
#pragma unroll
            for (int m = 0; m < 4; ++m) { const float rs = __builtin_amdgcn_rsqf(rss1[rowb + ai * 128 + m * 16] * (1.f / DM) + EPS);
#pragma unroll
                for (int bj = 0; bj < 2; ++bj) { const f32x4 s0 = acc[ai][bj][m][0] * rs, s1 = acc[ai][bj][m][1] * rs;
                    if (ai == 0 && m == 0) { if (wr == 0 && fr < 2) { float* p = Uh + ((size_t)pm * 4 + fr) * DFF2 + pn * 256 + bj * 128 + cl; *(f32x4*)p = s0; *(f32x4*)(p + 4) = s1; } }
                    if (ai == 1 && m == 3) { if (wr == 1 && fr >= 14) { float* p = Uh + ((size_t)pm * 4 + 2 + (fr - 14)) * DFF2 + pn * 256 + bj * 128 + cl; *(f32x4*)p = s0; *(f32x4*)(p + 4) = s1;
                            if ((pm & 15) == 15) { float* q = out + O_CVP + (size_t)((pm >> 4) * 2 + (fr - 14)) * DFF2 + bj * DFF + pn * 128 + cl; *(f32x4*)q = s0; *(f32x4*)(q + 4) = s1; } } }
                    P[ai][bj][m][0][0] = pk2(s0[0], s0[1]); P[ai][bj][m][0][1] = pk2(s0[2], s0[3]); P[ai][bj][m][1][0] = pk2(s1[0], s1[1]); P[ai][bj][m][1][1] = pk2(s1[2], s1[3]); } }
        if (fr >= 14) {
#pragma unroll
            for (int ai = 0; ai < 2; ++ai)
#pragma unroll
                for (int bj = 0; bj < 2; ++bj) { LAS unsigned* h = halo + ((((ai * 2 + wr) * 2 + (fr - 14)) * 2 + bj) * 64) + (cl >> 1);
                    *(LAS v4u*)h = (v4u){P[ai][bj][3][0][0], P[ai][bj][3][0][1], P[ai][bj][3][1][0], P[ai][bj][3][1][1]}; }
        }
        asm volatile("s_waitcnt lgkmcnt(0)" ::: "memory"); __builtin_amdgcn_s_barrier(); asm volatile("" ::: "memory");
        const bool l0 = fr == 0, l1 = fr == 1, l15 = fr == 15, l14 = fr >= 14;
#define DPPU(OLD, SRC, CTRL) ((unsigned)__builtin_amdgcn_update_dpp((int)(OLD), (int)(SRC), (CTRL), 0xf, 0xf, false))
#define LO16(W) __builtin_bit_cast(float, (W) << 16)
#define HI16(W) __builtin_bit_cast(float, (W) & 0xffff0000u)
#pragma unroll
        for (int ai = 0; ai < 2; ++ai) {
            const int pb = ai * 2 + wr - 1;
#pragma unroll
            for (int n = 0; n < 2; ++n) {
                f32x4 cvv[4];
#pragma unroll
                for (int bj = 0; bj < 2; ++bj) {
                    const int col = bj * DFF + pn * 128 + cl + 4 * n;
                    const f32x4 bb = *(const f32x4*)(bconv + col), w0 = *(const f32x4*)(wconv + col), w1 = *(const f32x4*)(wconv + (size_t)DFF2 + col), w2 = *(const f32x4*)(wconv + (size_t)2 * DFF2 + col);
                    unsigned c1[2], c2[2];
                    if (pb >= 0) { const LAS unsigned* h = halo + ((pb * 2 * 2 + bj) * 64) + (cl >> 1) + 2 * n; const v2u h2 = *(const LAS v2u*)h, h1 = *(const LAS v2u*)(h + 128);
#pragma unroll
                        for (int q = 0; q < 2; ++q) { c1[q] = l0 ? h1[q] : 0u; c2[q] = l0 ? h2[q] : (l1 ? h1[q] : 0u); } }
                    else { c1[0] = c1[1] = c2[0] = c2[1] = 0u; }
#pragma unroll
                    for (int m = 0; m < 4; ++m) { f32x4 cv;
#pragma unroll
                        for (int q = 0; q < 2; ++q) { const unsigned x = P[ai][bj][m][n][q]; const unsigned p1 = DPPU(c1[q], x, 0x111), p2 = DPPU(c2[q], x, 0x112);
                            cv[2 * q] = bb[2 * q] + w0[2 * q] * LO16(p2) + w1[2 * q] * LO16(p1) + w2[2 * q] * LO16(x);
                            cv[2 * q + 1] = bb[2 * q + 1] + w0[2 * q + 1] * HI16(p2) + w1[2 * q + 1] * HI16(p1) + w2[2 * q + 1] * HI16(x);
                            const unsigned e15 = l15 ? x : 0u, e14 = l14 ? x : 0u; c1[q] = DPPU(0u, e15, 0x121); c2[q] = DPPU(0u, e14, 0x122); }
                        if (bj == 0) cvv[m] = cv;
                        else { f32x4 o;
#pragma unroll
                            for (int k = 0; k < 4; ++k) { const float xg = cv[k], z = xg + 0.044715f * xg * xg * xg;
                                o[k] = cvv[m][k] * xg * __builtin_amdgcn_rcpf(1.f + __builtin_amdgcn_exp2f(-2.f * 0.7978845608028654f * LOG2E * z)); }
                            const int row = rowb + ai * 128 + m * 16;
                            if (!(ai == 0 && m == 0 && wr == 0 && fr < 2 && !bstart)) *(v2u*)(act + (size_t)(row - row0) * DFF + pn * 128 + cl + 4 * n) = pack4(o); }
                    }
                    asm volatile("" ::: "memory"); __builtin_amdgcn_sched_barrier(0);
                }
            }
        }
#undef DPPU
#undef LO16
#undef HI16
        asm volatile("s_waitcnt lgkmcnt(0)" ::: "memory"); __builtin_amdgcn_s_barrier(); asm volatile("" ::: "memory");
    }
};
struct EpiSlab {
    EPI_HDR
    float* slab;
    __device__ __forceinline__ void operator()(EPI_ARGS) const {
        const int rowb = u.pm * 256 + wr * 64 + fr - MP, c0 = u.pn * 256 + wc * 32 + 8 * fq, ks = u.kb / ((DFF / KSPLIT) * 2);
        EPI_ROWS { float* p = slab + ((size_t)ks * MS + rowb + ai * 128 + m * 16) * DM + c0;
#pragma unroll
            for (int bj = 0; bj < 2; ++bj) { *(f32x4*)(p + bj * 128) = acc[ai][bj][m][0]; *(f32x4*)(p + bj * 128 + 4) = acc[ai][bj][m][1]; } }
    }
};
struct EpiPle {
    EPI_HDR
    bf16* O;
    __device__ __forceinline__ void operator()(EPI_ARGS) const {
        const int rowb = u.pm * 256 + wr * 64 + fr, c0 = u.pn * 256 + wc * 32 + 8 * fq;
        EPI_ROWS { bf16* p = O + (size_t)(rowb + ai * 128 + m * 16) * DM + c0;
#pragma unroll
            for (int bj = 0; bj < 2; ++bj) *(v4u*)(p + bj * 128) = pack8(acc[ai][bj][m][0], acc[ai][bj][m][1]); }
    }
};

namespace att {
#ifndef ATT_THR
#define ATT_THR 0.0f
#endif
constexpr int SHM_V = 16384, SHM_K = 16384, SHM_KR = 8192;
constexpr int L_V = 0, L_K = 32768, L_KR = 65536, L_CK = 81920, L_WS = 82432, L_MM = 84480, L_END = 84544;
static_assert(L_END <= RING_BYTES, "attention LDS");
#define KSWZ(row, colB) ((row) * 256 + ((colB) ^ (((row) & 7) << 4)))
#define KRSWZ(row, colB) ((row) * 128 + ((colB) ^ ((((row) >> 1) & 7) << 4)))
#define SBAR() __builtin_amdgcn_sched_barrier(0)
__device__ __forceinline__ int crow(int r, int hi) { return (r & 3) + 8 * (r >> 2) + 4 * hi; }
__device__ __forceinline__ unsigned cvtpk(float lo, float hi) { return pk2(lo, hi); }
__device__ __forceinline__ int v_st(int k, int c) { const int kk = (k & ~0xC) | ((k & 4) << 1) | ((k & 8) >> 1); return ((kk >> 3) * 4 + (c >> 5)) * 512 + ((kk & 7) * 32 + (c & 31)) * 2; }
__device__ __forceinline__ int v_rd_base(int lane) { return ((lane & 3) << 3) | (((lane >> 2) & 3) << 6) | (((lane >> 4) & 1) << 5) | (((lane >> 5) & 1) << 8); }
constexpr int v_rd_off(int d0, int ks, int half) { return d0 * 512 + ks * 4096 + half * 2048; }
template <int OFF> __device__ __forceinline__ s16x4 tr_read(int vb) {
    s16x4 r; asm volatile("ds_read_b64_tr_b16 %0, %1 offset:%2" : "=&v"(r) : "v"(vb), "i"(OFF) : "memory"); return r;
}
template <int D0> __device__ __forceinline__ void pv_one(f32x16& od, int vb, bf16x8 pa0, bf16x8 pa1, bf16x8 pa2, bf16x8 pa3) {
    const s16x4 l0 = tr_read<v_rd_off(D0, 0, 0)>(vb), h0 = tr_read<v_rd_off(D0, 0, 1)>(vb), l1 = tr_read<v_rd_off(D0, 1, 0)>(vb), h1 = tr_read<v_rd_off(D0, 1, 1)>(vb);
    const s16x4 l2 = tr_read<v_rd_off(D0, 2, 0)>(vb), h2 = tr_read<v_rd_off(D0, 2, 1)>(vb), l3 = tr_read<v_rd_off(D0, 3, 0)>(vb), h3 = tr_read<v_rd_off(D0, 3, 1)>(vb);
    asm volatile("s_waitcnt lgkmcnt(0)" ::: "memory"); SBAR();
#define PK(L, H) (bf16x8){L[0], L[1], L[2], L[3], H[0], H[1], H[2], H[3]}
    od = __builtin_amdgcn_mfma_f32_32x32x16_bf16(pa0, PK(l0, h0), od, 0, 0, 0);
    od = __builtin_amdgcn_mfma_f32_32x32x16_bf16(pa1, PK(l1, h1), od, 0, 0, 0);
    od = __builtin_amdgcn_mfma_f32_32x32x16_bf16(pa2, PK(l2, h2), od, 0, 0, 0);
    od = __builtin_amdgcn_mfma_f32_32x32x16_bf16(pa3, PK(l3, h3), od, 0, 0, 0);
#undef PK
}
#define PK(L, H) (bf16x8){L[0], L[1], L[2], L[3], H[0], H[1], H[2], H[3]}
#define PV_READ(KS, L, H) do { L[0] = tr_read<v_rd_off(0, KS, 0)>(vb); H[0] = tr_read<v_rd_off(0, KS, 1)>(vb); L[1] = tr_read<v_rd_off(1, KS, 0)>(vb); H[1] = tr_read<v_rd_off(1, KS, 1)>(vb); \
        L[2] = tr_read<v_rd_off(2, KS, 0)>(vb); H[2] = tr_read<v_rd_off(2, KS, 1)>(vb); L[3] = tr_read<v_rd_off(3, KS, 0)>(vb); H[3] = tr_read<v_rd_off(3, KS, 1)>(vb); } while (0)
#define PV_MMA(PA, L, H) do { o[0] = __builtin_amdgcn_mfma_f32_32x32x16_bf16(PA, PK(L[0], H[0]), o[0], 0, 0, 0); o[1] = __builtin_amdgcn_mfma_f32_32x32x16_bf16(PA, PK(L[1], H[1]), o[1], 0, 0, 0); \
        o[2] = __builtin_amdgcn_mfma_f32_32x32x16_bf16(PA, PK(L[2], H[2]), o[2], 0, 0, 0); o[3] = __builtin_amdgcn_mfma_f32_32x32x16_bf16(PA, PK(L[3], H[3]), o[3], 0, 0, 0); } while (0)
__device__ __forceinline__ void pv_all(f32x16 (&o)[4], int vb, bf16x8 pa0, bf16x8 pa1, bf16x8 pa2, bf16x8 pa3) {
    s16x4 la[4], ha[4], lb[4], hb_[4];
    PV_READ(0, la, ha); PV_READ(1, lb, hb_);
    asm volatile("s_waitcnt lgkmcnt(8)" ::: "memory"); SBAR(); PV_MMA(pa0, la, ha);
    PV_READ(2, la, ha);
    asm volatile("s_waitcnt lgkmcnt(8)" ::: "memory"); SBAR(); PV_MMA(pa1, lb, hb_);
    PV_READ(3, lb, hb_);
    asm volatile("s_waitcnt lgkmcnt(8)" ::: "memory"); SBAR(); PV_MMA(pa2, la, ha);
    asm volatile("s_waitcnt lgkmcnt(0)" ::: "memory"); SBAR(); PV_MMA(pa3, lb, hb_);
}
#undef PV_READ
#undef PV_MMA
#undef PK
struct Tensors { const bf16* Q; const bf16* K; const bf16* V; const bf16* KR; const float* ncumP; const float* ncumS; bf16* O; const unsigned* qkmax; const float* Kc; const float* Vc; const float* Kn; const float* Vn; };

template <bool FOX, bool F32 = false>
__device__ __forceinline__ void attn_unit(const Tensors& T, bool sample, int b, int h, int qb, LAS unsigned char* lds, const int wave_id) {
    constexpr int NQ0 = FOX ? 8 : 12, LDQ = FOX ? FW : NQ, QH = FOX ? HD : 192;
    int tid_ = wave_id * 64 + lane_id_nv(); asm volatile("" : "+v"(tid_));
    const int tid = tid_, wid = __builtin_amdgcn_readfirstlane(tid >> 6), lane = tid & 63, r32 = lane & 31, hi = lane >> 5;
    int kvrow0, nt, qidx0, qrow_w; bool active;
    if (!sample) { kvrow0 = b * TP; nt = 4 * qb + 4; qidx0 = qb * 256 + 32 * wid; qrow_w = b * TP + qidx0; active = true; }
    else { kvrow0 = MP + b * SKV; nt = 33; qidx0 = PAST; qrow_w = MP + b * TS; active = (wid == 0); }
    int jfull, jmax, limit;
    if (FOX) { limit = qidx0 + r32; jfull = (qidx0 + 1) >> 6; jmax = (qidx0 + 31) >> 6; }
    else if (!sample) { jmax = qidx0 >> 6; jfull = jmax + 1; limit = 0x7fffffff; }
    else { jmax = 32; jfull = 32; limit = SKV - 1; }
    if (!active) jmax = -1;
    LAS float* ws = (LAS float*)(lds + L_WS) + wid * 64; LAS float* li_l = ws; LAS float* al_l = ws + 32;
    float m_reg = -1e30f, l_reg = 0.f; f32x16 o[4];
#pragma unroll
    for (int d = 0; d < 4; ++d)
#pragma unroll
        for (int r = 0; r < 16; ++r) o[d][r] = 0.f;
    bf16x8 qr[NQ0];
    { const bf16* Qw = T.Q + (size_t)(qrow_w + r32) * LDQ + h * QH + hi * 8;
#pragma unroll
      for (int d0 = 0; d0 < NQ0; ++d0) qr[d0] = *(const bf16x8*)(Qw + d0 * 16); }
    const bf16* Kh = T.K + (size_t)kvrow0 * 1024 + h * HD; const bf16* Vh = T.V + (size_t)kvrow0 * 1024 + h * HD;
    const bf16* KRh = T.KR + (size_t)kvrow0 * 64; const float* CKh = sample ? T.ncumS + (size_t)(b * NH + h) * SCUM : T.ncumP + (size_t)(b * NH + h) * TP;
    const int sr = tid >> 4, sc = (tid & 15) * 8, vst0 = v_st(sr, sc), vst1 = v_st(32 + sr, sc), krr = tid >> 3, krc = (tid & 7) * 8;
    const int vb0 = (int)(uintptr_t)(lds + L_V) + v_rd_base(lane);
    unsigned kq[4], rq[4];
#pragma unroll
    for (int q = 0; q < 4; ++q) { kq[q] = (unsigned)KSWZ(r32, (q * 16 + hi * 8) * 2); rq[q] = (unsigned)KRSWZ(r32, (q * 16 + hi * 8) * 2); }
    bf16x8 sv0, sv1, sk0, sk1, skr; f32x4 sck; f32x4 fv0[2], fv1[2], fk0[2], fk1[2];
    const float* Kcf = nullptr; const float* Vcf = nullptr; const float* Knf = nullptr; const float* Vnf = nullptr;
    if (F32) { Kcf = T.Kc + (size_t)b * PAST * 1024 + h * HD + sc; Vcf = T.Vc + (size_t)b * PAST * 1024 + h * HD + sc; Knf = T.Kn + (size_t)(MP + b * TS) * 1024 + h * HD + sc; Vnf = T.Vn + (size_t)(MP + b * TS) * 1024 + h * HD + sc; }
#define LD8F(DST, P) do { DST[0] = *(const f32x4*)(P); DST[1] = *(const f32x4*)((P) + 4); } while (0)
#define SLOAD(k0) do { if (F32) { const f32x4 z4 = {0.f, 0.f, 0.f, 0.f}; \
            if ((k0) < PAST) { LD8F(fv0, Vcf + (size_t)((k0) + sr) * 1024); LD8F(fv1, Vcf + (size_t)((k0) + 32 + sr) * 1024); LD8F(fk0, Kcf + (size_t)((k0) + sr) * 1024); LD8F(fk1, Kcf + (size_t)((k0) + 32 + sr) * 1024); } \
            else { LD8F(fv0, Vnf + (size_t)sr * 1024); LD8F(fk0, Knf + (size_t)sr * 1024); fv1[0] = fv1[1] = fk1[0] = fk1[1] = z4; }     \
        } else { sv0 = *(const bf16x8*)(Vh + (size_t)((k0) + sr) * 1024 + sc); sv1 = *(const bf16x8*)(Vh + (size_t)((k0) + 32 + sr) * 1024 + sc); \
        sk0 = *(const bf16x8*)(Kh + (size_t)((k0) + sr) * 1024 + sc); sk1 = *(const bf16x8*)(Kh + (size_t)((k0) + 32 + sr) * 1024 + sc); } \
        if (!FOX) skr = *(const bf16x8*)(KRh + (size_t)((k0) + krr) * 64 + krc); \
        if (FOX) { if (tid < 16) sck = *(const f32x4*)(CKh + (k0) + 4 * tid); } } while (0)
#define SWRITE(bf) do { if (F32) { sv0 = __builtin_bit_cast(bf16x8, pack8(fv0[0], fv0[1])); sv1 = __builtin_bit_cast(bf16x8, pack8(fv1[0], fv1[1])); sk0 = __builtin_bit_cast(bf16x8, pack8(fk0[0], fk0[1])); sk1 = __builtin_bit_cast(bf16x8, pack8(fk1[0], fk1[1])); } \
        *(LAS bf16x8*)(lds + L_V + (bf) * SHM_V + vst0) = sv0; *(LAS bf16x8*)(lds + L_V + (bf) * SHM_V + vst1) = sv1; \
        *(LAS bf16x8*)(lds + L_K + (bf) * SHM_K + KSWZ(sr, sc * 2)) = sk0; *(LAS bf16x8*)(lds + L_K + (bf) * SHM_K + KSWZ(32 + sr, sc * 2)) = sk1; \
        if (!FOX) *(LAS bf16x8*)(lds + L_KR + (bf) * SHM_KR + KRSWZ(krr, krc * 2)) = skr; \
        if (FOX) { if (tid < 16) *(LAS f32x4*)(lds + L_CK + (bf) * 256 + tid * 16) = sck; } } while (0)
    float sbound = 0.f;
    if (FOX) sbound = 1.01f * sqrtf(__builtin_bit_cast(float, __builtin_amdgcn_readfirstlane(T.qkmax[0])) * __builtin_bit_cast(float, __builtin_amdgcn_readfirstlane(T.qkmax[64])));
    LAS float* mm = (LAS float*)(lds + L_MM);
    SLOAD((nt - 1) * 64); SWRITE(0); __syncthreads();
    for (int jj = 0; jj < nt; ++jj) {
        const int j = nt - 1 - jj, bf = jj & 1;
        if (jj + 1 < nt) SLOAD((j - 1) * 64);
        if (j <= jmax) {
            f32x16 p0, p1;
            if (FOX) { const LAS f32x4* ckp = (const LAS f32x4*)(lds + L_CK + bf * 256);
#pragma unroll
                for (int g = 0; g < 4; ++g) { const f32x4 a = ckp[2 * g + hi], c = ckp[8 + 2 * g + hi];
                    p0[4 * g] = a[0]; p0[4 * g + 1] = a[1]; p0[4 * g + 2] = a[2]; p0[4 * g + 3] = a[3]; p1[4 * g] = c[0]; p1[4 * g + 1] = c[1]; p1[4 * g + 2] = c[2]; p1[4 * g + 3] = c[3]; } }
            else {
#pragma unroll
                for (int r = 0; r < 16; ++r) { p0[r] = 0.f; p1[r] = 0.f; } }
            {
                const unsigned kbase = (unsigned)(uintptr_t)(lds + L_K) + (unsigned)bf * SHM_K, rbase = (unsigned)(uintptr_t)(lds + L_KR) + (unsigned)bf * SHM_KR;
#define KREAD(DST, ADDR, OFF) asm volatile("ds_read_b128 %0, %1 offset:%2" : "=&v"(DST) : "v"(ADDR), "i"(OFF) : "memory")
#define KSTEP_READ(D0) do { if ((D0) < 8) { KREAD(ka[(D0) & 3], kbase + kq[(D0) & 3], ((D0) >> 2) * 128); KREAD(kb_[(D0) & 3], kbase + kq[(D0) & 3], ((D0) >> 2) * 128 + 8192); } \
                            else { KREAD(ka[(D0) & 3], rbase + rq[(D0) & 3], 0); KREAD(kb_[(D0) & 3], rbase + rq[(D0) & 3], 4096); } } while (0)
                bf16x8 ka[4], kb_[4];
                KSTEP_READ(0); KSTEP_READ(1); KSTEP_READ(2); KSTEP_READ(3);
                __builtin_amdgcn_s_setprio(1);
#pragma unroll
                for (int d0 = 0; d0 < NQ0; ++d0) {
                    if (d0 + 3 < NQ0) asm volatile("s_waitcnt lgkmcnt(6)" ::: "memory"); else if (d0 + 2 < NQ0) asm volatile("s_waitcnt lgkmcnt(4)" ::: "memory");
                    else if (d0 + 1 < NQ0) asm volatile("s_waitcnt lgkmcnt(2)" ::: "memory"); else asm volatile("s_waitcnt lgkmcnt(0)" ::: "memory");
                    SBAR();
                    const bf16x8 a = ka[d0 & 3], b = kb_[d0 & 3];
                    p0 = __builtin_amdgcn_mfma_f32_32x32x16_bf16(a, qr[d0], p0, 0, 0, 0); p1 = __builtin_amdgcn_mfma_f32_32x32x16_bf16(b, qr[d0], p1, 0, 0, 0);
                    SBAR();
                    if (d0 + 4 < NQ0) { if (d0 + 4 == 4) { KSTEP_READ(4); } else if (d0 + 4 == 5) { KSTEP_READ(5); } else if (d0 + 4 == 6) { KSTEP_READ(6); } else if (d0 + 4 == 7) { KSTEP_READ(7); }
                        else if (d0 + 4 == 8) { KSTEP_READ(8); } else if (d0 + 4 == 9) { KSTEP_READ(9); } else if (d0 + 4 == 10) { KSTEP_READ(10); } else { KSTEP_READ(11); } }
                }
                __builtin_amdgcn_s_setprio(0);
#undef KSTEP_READ
#undef KREAD
            }
            if (j >= jfull) { const int kb = 64 * j + 4 * hi;
#pragma unroll
                for (int r = 0; r < 16; ++r) { const int kv = kb + (r & 3) + 8 * (r >> 2); if (kv > limit) p0[r] = -1e30f; if (kv + 32 > limit) p1[r] = -1e30f; } }
            float pmax = p0[0];
#pragma unroll
            for (int r = 1; r < 16; ++r) pmax = fmaxf(pmax, p0[r]);
#pragma unroll
            for (int r = 0; r < 16; ++r) pmax = fmaxf(pmax, p1[r]);
            { auto rr = __builtin_amdgcn_permlane32_swap(__float_as_uint(pmax), __float_as_uint(pmax), false, false); pmax = fmaxf(__uint_as_float(rr[0]), __uint_as_float(rr[1])); }
            float alpha = 1.f;
            if (!__all(pmax - m_reg <= ATT_THR)) {
                const float mn = fmaxf(m_reg, pmax); alpha = __builtin_amdgcn_exp2f(m_reg - mn); m_reg = mn;
                if (hi == 0) al_l[r32] = alpha; LDS_WAIT();
#pragma unroll
                for (int r = 0; r < 16; ++r) { const float a = al_l[crow(r, hi)];
#pragma unroll
                    for (int d = 0; d < 4; ++d) o[d][r] *= a; }
            }
#pragma unroll
            for (int r = 0; r < 16; ++r) { p0[r] = __builtin_amdgcn_exp2f(p0[r] - m_reg); p1[r] = __builtin_amdgcn_exp2f(p1[r] - m_reg); }
            float ps = 0.f;
#pragma unroll
            for (int r = 0; r < 16; ++r) ps += p0[r] + p1[r];
            { auto rr = __builtin_amdgcn_permlane32_swap(__float_as_uint(ps), __float_as_uint(ps), false, false); ps = __uint_as_float(rr[0]) + __uint_as_float(rr[1]); }
            l_reg = l_reg * alpha + ps;
            bf16x8 pa0, pa1, pa2, pa3;
#define PK4(P, BASE, OUT) do { unsigned a0 = cvtpk(P[BASE + 0], P[BASE + 1]), a1 = cvtpk(P[BASE + 2], P[BASE + 3]);   \
    unsigned b0 = cvtpk(P[BASE + 4], P[BASE + 5]), b1 = cvtpk(P[BASE + 6], P[BASE + 7]);                              \
    auto r0 = __builtin_amdgcn_permlane32_swap(a0, b0, false, false); auto r1 = __builtin_amdgcn_permlane32_swap(a1, b1, false, false); \
    v4u w = {r0[0], r1[0], r0[1], r1[1]}; OUT = __builtin_bit_cast(bf16x8, w); } while (0)
            PK4(p0, 0, pa0); PK4(p0, 8, pa1); PK4(p1, 0, pa2); PK4(p1, 8, pa3);
#undef PK4
            const int vb = vb0 + bf * SHM_V;
            __builtin_amdgcn_s_setprio(1); pv_all(o, vb, pa0, pa1, pa2, pa3); __builtin_amdgcn_s_setprio(0);
        }
        if (jj + 1 < nt) SWRITE(bf ^ 1);
        float nextb = 0.f;
        if (FOX) { if (j > 0) nextb = CKh[(j - 1) * 64 + 63];
            float mw = active ? m_reg : 1e30f;
#pragma unroll
            for (int o_ = 1; o_ < 64; o_ <<= 1) mw = fminf(mw, __shfl_xor(mw, o_));
            if (lane == 0) mm[(jj & 1) * 8 + wid] = mw; }
        __syncthreads();
        if (FOX) { const f32x4 m0 = *(const LAS f32x4*)(mm + (jj & 1) * 8), m1 = *(const LAS f32x4*)(mm + (jj & 1) * 8 + 4);
            const float mall = fminf(fminf(fminf(m0[0], m0[1]), fminf(m0[2], m0[3])), fminf(fminf(m1[0], m1[1]), fminf(m1[2], m1[3])));
            if (j > 0 && sbound + nextb - mall < -140.f) break; }
    }
    if (active) {
        if (hi == 0) li_l[r32] = l_reg; LDS_WAIT();
        bf16* Ow = T.O + (size_t)qrow_w * 1024 + h * HD + r32;
#pragma unroll
        for (int r = 0; r < 16; ++r) { const int orow = crow(r, hi); const float rl = __builtin_amdgcn_rcpf(li_l[orow]);
#pragma unroll
            for (int d0 = 0; d0 < 4; ++d0) Ow[(size_t)orow * 1024 + d0 * 32] = (bf16)f2bf(o[d0][r] * rl); }
    }
#undef SLOAD
#undef SWRITE
#undef LD8F
}
constexpr int NUNITS = 16 * 64 + 128;
template <bool FOX>
__device__ __forceinline__ void attn_phase(const Tensors& T, gu32* qhead, LAS unsigned char* lds, volatile LAS unsigned* misc, const int wave_id) {
    for (;;) {
        if (wave_id == 0 && (unsigned)lane_id_nv() == 0) misc[0] = __hip_atomic_fetch_add(qhead, 1u, RLX_AGENT);
        __syncthreads();
        const int idx = (int)misc[0];
        if (idx >= NUNITS) break;
        bool sample = false; int b, h, qb = 0;
        if (idx >= 512 && idx < 640) { sample = true; const int s = idx - 512; b = s >> 3; h = s & 7; }
        else { const int i2 = idx < 512 ? idx : idx - 128; qb = 15 - (i2 >> 6); const int bh = i2 & 63; b = bh >> 3; h = bh & 7; }
        if (FOX && sample) attn_unit<FOX, FOX>(T, sample, b, h, qb, lds, wave_id); else attn_unit<FOX, false>(T, sample, b, h, qb, lds, wave_id);
    }
    __syncthreads();
}
#undef KSWZ
#undef KRSWZ
#undef SBAR
}

struct Args { const float* in[29]; float* out; unsigned char* ws; int ph_lo, ph_hi; };
static_assert(sizeof(Args) == 29 * 8 + 8 + 8 + 8, "Args has no padding");
enum { I_XP = 0, I_XS, I_CCKV, I_CKR, I_CFK, I_CFV, I_CLF, I_CONV, I_PP, I_PS, I_GMIX, I_WIN, I_BF, I_GQ, I_WUQ, I_GKV, I_WUKV, I_WOA, I_WOB, I_WO, I_GFFN, I_WUP, I_WCONV, I_BCONV,
       I_WDN, I_GPLE, I_WPG, I_WPLE, I_GFIN };

#define CAS __attribute__((address_space(4)))
__device__ __forceinline__ const float* arg_in(int k) { const CAS char* ka = (const CAS char*)__builtin_amdgcn_kernarg_segment_ptr(); return *(const float* const volatile CAS*)(ka + 8 * k); }
template <int MAP> __device__ __forceinline__ int dst_row(int j) {
    if (MAP == 0) return j;
    if (MAP == 1) {
        if (j < 1024) return j;
        if (j < 1088) { const int e = j - 1024; return e < 32 ? 1024 + 2 * e : 1024 + 2 * (e - 32) + 1; }
        if (j < 4160) return j + 192;
        if (j < 4168) return 1088 + (j - 4160);
        return j + 184;
    }
    if (MAP == 3) { const bool gate = j >= DFF; const int jj = gate ? j - DFF : j; return (jj >> 7) * 256 + (gate ? 128 : 0) + (jj & 127); }
    { const int h = j / 192, d = j - h * 192;
      if (d < 128) return h * 128 + d; const int e = d - 128; return 1024 + h * 64 + (e < 32 ? 2 * e : 2 * (e - 32) + 1); }
}
template <int MAP> __device__ __forceinline__ void tr_item(const float* W, int K, int N, const float* gain, bf16* WT, LAS float* scr, int item, int lane) {
    const int nblk = (N + 31) / 32, kb = item / nblk, nb = item - kb * nblk, k0 = 64 * kb, n0 = 32 * nb;
    const int col = n0 + (lane & 31); const bool okc = col < N;
    float vv[32];
#pragma unroll
    for (int i = 0; i < 32; ++i) { const int kk = 2 * i + (lane >> 5); vv[i] = okc ? W[(size_t)(k0 + kk) * N + col] : 0.f; }
#pragma unroll
    for (int i = 0; i < 32; ++i) { const int kk = 2 * i + (lane >> 5); float v = vv[i]; if (gain) v *= gain[k0 + kk]; scr[kk * 33 + (lane & 31)] = v; }
    LDS_WAIT(); asm volatile("" ::: "memory");
    const int c = lane & 7;
#pragma unroll
    for (int j = 0; j < 4; ++j) { const int n = (lane >> 3) + 8 * j; const LAS float* s = scr + (8 * c) * 33 + n;
        v4u o; o.x = pk2(s[0 * 33], s[1 * 33]); o.y = pk2(s[2 * 33], s[3 * 33]); o.z = pk2(s[4 * 33], s[5 * 33]); o.w = pk2(s[6 * 33], s[7 * 33]);
        if (n0 + n < N) *(v4u*)(WT + (size_t)dst_row<MAP>(n0 + n) * K + k0 + 8 * c) = o; }
    LDS_WAIT(); asm volatile("" ::: "memory");
}
__device__ __forceinline__ void cvt8(const float* s, bf16* d) { const f32x4 a = *(const f32x4*)s, b = *(const f32x4*)(s + 4); *(v4u*)d = pack8(a, b); }

__global__ void __launch_bounds__(NWAVES * 64, 2) mega_fwd(Args args) {
    extern __shared__ __attribute__((aligned(16))) unsigned char lds_raw[];
    LAS unsigned char* lds = (LAS unsigned char*)lds_raw;
    volatile LAS unsigned* MISC = (volatile LAS unsigned*)(lds + MISC_OFF);
#define lane (lane_id_nv())
#define tid (wave * 64 + lane)
    const int wave = __builtin_amdgcn_readfirstlane(threadIdx.x >> 6);
    const int G = gridDim.x; const int bx = blockIdx.x; const int vcu = (G % 8 == 0) ? (bx % 8) * (G / 8) + bx / 8 : bx;
    unsigned char* ws = args.ws; float* out = args.out;
    gu32* ctl = (gu32*)(ws + WS_CTL);
    for (int u = tid; u < (LDS_BYTES - LDSCTL_OFF) / 4; u += NWAVES * 64) ((LAS unsigned*)(lds + LDSCTL_OFF))[u] = 0u;
    __syncthreads();
    XcdBarrier bar = xcd_barrier_post((unsigned*)(ws + WS_CTL) + CW_BAR, MISC + 8);
    const int lo = args.ph_lo, hi = args.ph_hi;
#ifndef ALIGN_P1
#define ALIGN_P1 true
#endif
#ifndef ALIGN_HEAVY
#define ALIGN_HEAVY true
#endif
#ifndef PHMASK
#define PHMASK 0xFFFFFFFFu
#endif
#define IN(k) (((PHMASK >> ((k) < 9 ? (k) : ((k) < 18 ? 9 + ((k) - 9) % 3 : (k) - 6))) & 1u) && lo <= (k) && (k) < hi)
#define SEAM(k) do { if (IN(k) && IN((k) + 1)) xcd_barrier(bar); } while (0)
#define ropec ((float*)(ws + WS_ROPE))
#define ropes (((float*)(ws + WS_ROPE)) + TP * 32)
#define ncumP ((float*)(ws + WS_NCUMP))
#define ncumS ((float*)(ws + WS_NCUMS))
#define rss1 ((float*)(ws + WS_RSS))
#define rss2 (((float*)(ws + WS_RSS)) + MT)
#define rss3 (((float*)(ws + WS_RSS)) + 2 * MT)
#define pe_bf ((bf16*)(ws + WS_PE))
#define kr_all ((bf16*)(ws + WS_KR))
#define Wt_in ((bf16*)(ws + WS_WIN))
#define Wt_uq ((bf16*)(ws + WS_WUQ))
#define Wt_ukv ((bf16*)(ws + WS_WUKV))
#define Wt_oa ((bf16*)(ws + WS_WOA))
#define Wt_ob ((bf16*)(ws + WS_WOB))
#define Wt_o ((bf16*)(ws + WS_WO))
#define Wt_up ((bf16*)(ws + WS_WUP))
#define Wt_dn ((bf16*)(ws + WS_WDN))
#define Wt_pg ((bf16*)(ws + WS_WPG))
#define Wt_ple ((bf16*)(ws + WS_WPLE))
#define fk_all ((bf16*)(ws + WS_FK))
#define fv_all ((bf16*)(ws + WS_FV))
#define fq ((bf16*)(ws + WS_FQ))
#define ckv_all ((bf16*)(ws + WS_CKV))
#define cqn ((bf16*)(ws + WS_CQN))
#define Qm ((bf16*)(ws + WS_QM))
#define Km ((bf16*)(ws + WS_KM))
#define Vm ((bf16*)(ws + WS_VM))
#define A0 ((bf16*)(ws + WS_A0))
#define cq_raw ((float*)(ws + WS_CQR))
#define o_a ((bf16*)(ws + WS_OA))
#define o_b ((bf16*)(ws + WS_OB))
#define mg ((bf16*)(ws + WS_MG))
#define hb ((bf16*)(ws + WS_HB))
#define Ubuf ((bf16*)(ws + WS_U))
#define actb ((bf16*)(ws + WS_ACT))
#define hb2 ((bf16*)(ws + WS_HB2))
#define pleo ((bf16*)(ws + WS_PLEO))
#define A0b ((bf16*)(ws + WS_A0B))
#define sga ((bf16*)out)
#define sgb (((bf16*)out) + (size_t)MT * DM)
#define sgS ((bf16*)(ws + WS_SGS))
#define slab ((float*)(ws + WS_SLAB))
#define Uh ((float*)(ws + WS_UH))
#define gw (vcu * NWAVES + wave)
#define NGW (G * NWAVES)
#define gt ((size_t)vcu * (NWAVES * 64) + (size_t)tid)
#define NT ((size_t)G * NWAVES * 64)

#define A0_ROWS(DST, NROWS) do { for (int row = gw; row < (NROWS); row += NGW) { \
            const float* xr = row < MP ? arg_in(I_XP) + (size_t)row * DM : arg_in(I_XS) + (size_t)(row - MP) * DM; \
            f32x4 v[8]; float ss = 0.f; \
            _Pragma("unroll") for (int j = 0; j < 8; ++j) { v[j] = *(const f32x4*)(xr + 4 * lane + 256 * j); ss += (v[j][0] * v[j][0] + v[j][1] * v[j][1]) + (v[j][2] * v[j][2] + v[j][3] * v[j][3]); } \
            const float rs = 1.f / sqrtf(wave_sum(ss) * (1.f / DM) + EPS); \
            _Pragma("unroll") for (int j = 0; j < 8; ++j) { const f32x4 g = *(const f32x4*)(arg_in(I_GMIX) + 4 * lane + 256 * j); *(v2u*)((DST) + (size_t)row * DM + 4 * lane + 256 * j) = pack4(v[j] * rs * g); } } } while (0)

#if defined(REPEAT0)
    for (int rep0 = 0; rep0 < 2; ++rep0)
#endif
    if (IN(0)) {
        LAS float* scr = (LAS float*)(lds + RING_OFF + wave * 16384);
        {
            constexpr int I_IN = 32 * 259, I_UQ = 8 * 48, I_UKV = 8 * 64, I_OA = 16 * 64, I_O = 32 * 64, I_UP = 32 * 352, I_DN = 88 * 64, I_PLE = 4 * 64;
            constexpr int NITEMS = I_IN + I_UQ + I_UKV + 2 * I_OA + 2 * I_O + I_UP + I_DN + I_PLE;
            for (int it = gw; it < NITEMS; it += NGW) {
                int r = it;
                if (r < I_UP) { tr_item<3>(arg_in(I_WUP), DM, DFF2, arg_in(I_GFFN), Wt_up, scr, r, lane); continue; } r -= I_UP;
                if (r < I_IN) { tr_item<1>(arg_in(I_WIN), DM, INW, nullptr, Wt_in, scr, r, lane); continue; } r -= I_IN;
                if (r < I_DN) { tr_item<0>(arg_in(I_WDN), DFF, DM, nullptr, Wt_dn, scr, r, lane); continue; } r -= I_DN;
                if (r < I_O) { tr_item<0>(arg_in(I_WO), DM, DM, nullptr, Wt_o, scr, r, lane); continue; } r -= I_O;
                if (r < I_O) { tr_item<0>(arg_in(I_WPG), DM, DM, arg_in(I_GPLE), Wt_pg, scr, r, lane); continue; } r -= I_O;
                if (r < I_OA) { tr_item<0>(arg_in(I_WOA), FW, DM, nullptr, Wt_oa, scr, r, lane); continue; } r -= I_OA;
                if (r < I_OA) { tr_item<0>(arg_in(I_WOB), FW, DM, nullptr, Wt_ob, scr, r, lane); continue; } r -= I_OA;
                if (r < I_UKV) { tr_item<0>(arg_in(I_WUKV), KVR, NKV, nullptr, Wt_ukv, scr, r, lane); continue; } r -= I_UKV;
                if (r < I_UQ) { tr_item<2>(arg_in(I_WUQ), QR, NQ, nullptr, Wt_uq, scr, r, lane); continue; } r -= I_UQ;
                tr_item<0>(arg_in(I_WPLE), PLE, DM, nullptr, Wt_ple, scr, r, lane);
            }
        }
        A0_ROWS(A0, MT);
#define CVT_LOOP(N8, SRCP, DSTP) do { for (size_t e0 = gt; e0 < (size_t)(N8); e0 += 4 * NT) { f32x4 ca[4], cb[4]; \
            _Pragma("unroll") for (int q = 0; q < 4; ++q) { const size_t e = e0 + q * NT; if (e < (size_t)(N8)) { const size_t e8 = e * 8; const float* sp = (SRCP); ca[q] = *(const f32x4*)sp; cb[q] = *(const f32x4*)(sp + 4); } } \
            _Pragma("unroll") for (int q = 0; q < 4; ++q) { const size_t e = e0 + q * NT; if (e < (size_t)(N8)) { const size_t e8 = e * 8; *(v4u*)(DSTP) = pack8(ca[q], cb[q]); } } } } while (0)
#define CROW(e8, W) ((size_t)(MP + (int)(((e8) / (W)) >> 11) * SKV + (int)(((e8) / (W)) & 2047)) * (W) + ((e8) % (W)))
        CVT_LOOP((size_t)MT * PLE / 8, (e8 < (size_t)MP * PLE ? arg_in(I_PP) + e8 : arg_in(I_PS) + (e8 - (size_t)MP * PLE)), pe_bf + e8);
        CVT_LOOP((size_t)NBS * PAST * KVR / 8, arg_in(I_CCKV) + e8, ckv_all + CROW(e8, KVR));
        CVT_LOOP((size_t)NBS * PAST * ROPE / 8, arg_in(I_CKR) + e8, kr_all + CROW(e8, ROPE));
        { const v4u z = {0u, 0u, 0u, 0u};
          for (size_t e = gt; e < (size_t)184 * DM / 8; e += NT) *(v4u*)(Wt_in + (size_t)1096 * DM + e * 8) = z;
          for (size_t e = gt; e < (size_t)64 * 1024 / 8; e += NT) { *(v4u*)(fk_all + (size_t)RKV * 1024 + e * 8) = z; *(v4u*)(fv_all + (size_t)RKV * 1024 + e * 8) = z; }
          for (size_t e = gt; e < (size_t)64 * 64 / 8; e += NT) *(v4u*)(kr_all + (size_t)RKV * 64 + e * 8) = z;
          for (size_t e = gt; e < (size_t)3 * MT; e += NT) rss1[e] = 0.f; }
        for (size_t e = gt; e < (size_t)TP * 32; e += NT) { const int pos = (int)(e >> 5), i = (int)(e & 31);
            const float inv = (float)pow(10000.0, -(double)i / 32.0); const float ang = (float)pos * inv; ropec[e] = (float)cos((double)ang); ropes[e] = (float)sin((double)ang); }
    }
    SEAM(0);

#if defined(REPEAT1)
    for (int rep1 = 0; rep1 < 2; ++rep1)
#endif
    if (IN(1)) {
        pg8::Gemm g{A0, Wt_in, MT, NIN, DM}; TileOrder S; S.init(MT / 256, NIN / 256, G, bx, 0);
        EpiIn E{out, cq_raw, kr_all, fq, fk_all, fv_all, sga, sgb, ropec, ropes, arg_in(I_BF)};
        pg8::gemm_phase<EpiIn, TileOrder, true, true>(lds + RING_OFF, g, S, E, wave);
    }
    SEAM(1);

    if (IN(2)) {
        for (int row = gw; row < MT; row += NGW) {
            { const float* p = cq_raw + (size_t)row * QR + 4 * lane; const f32x4 a = *(const f32x4*)p, b = *(const f32x4*)(p + 256);
              const float ss = (a[0] * a[0] + a[1] * a[1]) + (a[2] * a[2] + a[3] * a[3]) + (b[0] * b[0] + b[1] * b[1]) + (b[2] * b[2] + b[3] * b[3]);
              const float rs = 1.f / sqrtf(wave_sum(ss) * (1.f / QR) + EPS); const float* gq = arg_in(I_GQ) + 4 * lane;
              *(v2u*)(cqn + (size_t)row * QR + 4 * lane) = pack4(a * rs * *(const f32x4*)gq); *(v2u*)(cqn + (size_t)row * QR + 4 * lane + 256) = pack4(b * rs * *(const f32x4*)(gq + 256)); }
            { float* p = out + O_CKV + (size_t)row * KVR + 4 * lane; const f32x4 a = *(const f32x4*)p, b = *(const f32x4*)(p + 256);
              const float ss = (a[0] * a[0] + a[1] * a[1]) + (a[2] * a[2] + a[3] * a[3]) + (b[0] * b[0] + b[1] * b[1]) + (b[2] * b[2] + b[3] * b[3]);
              const float rs = 1.f / sqrtf(wave_sum(ss) * (1.f / KVR) + EPS); const float* gk = arg_in(I_GKV) + 4 * lane;
              const f32x4 na = a * rs * *(const f32x4*)gk, nb = b * rs * *(const f32x4*)(gk + 256);
              *(f32x4*)p = na; *(f32x4*)(p + 256) = nb; bf16* d = ckv_all + (size_t)kvrow_of(row) * KVR + 4 * lane; *(v2u*)d = pack4(na); *(v2u*)(d + 256) = pack4(nb); }
        }
        { const v4u z = {0u, 0u, 0u, 0u};
          for (size_t e = gt; e < (size_t)64 * 1024 / 8; e += NT) { *(v4u*)(Km + (size_t)RKV * 1024 + e * 8) = z; *(v4u*)(Vm + (size_t)RKV * 1024 + e * 8) = z; } }
    }
    SEAM(2);

    if (IN(3)) {
        { pg8::Gemm g{cqn, Wt_uq, MT, NQ, QR}; TileOrder S; S.init(MT / 256, NQ / 256, G, bx, 0); EpiQ E{Qm, ropec, ropes};
          pg8::gemm_phase<EpiQ, TileOrder, true, true>(lds + RING_OFF, g, S, E, wave); }
        { pg8::Gemm g{ckv_all, Wt_ukv, RKV, NKV, KVR}; TileOrder S; S.init(RKV / 256, NKV / 256, G, bx, 0); EpiKV E{Km, Vm};
          pg8::gemm_phase<EpiKV, TileOrder, true, true>(lds + RING_OFF, g, S, E, wave); }
        {
            float qm = 0.f, km = 0.f;
            for (int r = gw; r < 2 * MT; r += NGW) { const bool isq = r < MT; const bf16* p = (isq ? fq + (size_t)r * FW : fk_all + (size_t)kvrow_of(r - MT) * FW) + 16 * lane;
                f32x4 a0, a1, b0, b1; unpack8(*(const v4u*)p, a0, a1); unpack8(*(const v4u*)(p + 8), b0, b1);
                float ss = (a0[0] * a0[0] + a0[1] * a0[1]) + (a0[2] * a0[2] + a0[3] * a0[3]) + (a1[0] * a1[0] + a1[1] * a1[1]) + (a1[2] * a1[2] + a1[3] * a1[3])
                         + (b0[0] * b0[0] + b0[1] * b0[1]) + (b0[2] * b0[2] + b0[3] * b0[3]) + (b1[0] * b1[0] + b1[1] * b1[1]) + (b1[2] * b1[2] + b1[3] * b1[3]);
                ss += __shfl_xor(ss, 1); ss += __shfl_xor(ss, 2); ss += __shfl_xor(ss, 4);
                if (isq) qm = fmaxf(qm, ss); else km = fmaxf(km, ss); }
            for (int r = gw; r < NBS * PAST; r += NGW) { const float* p = arg_in(I_CFK) + (size_t)r * FW + 16 * lane;
                const f32x4 a0 = *(const f32x4*)p, a1 = *(const f32x4*)(p + 4), b0 = *(const f32x4*)(p + 8), b1 = *(const f32x4*)(p + 12);
                float ss = (a0[0] * a0[0] + a0[1] * a0[1]) + (a0[2] * a0[2] + a0[3] * a0[3]) + (a1[0] * a1[0] + a1[1] * a1[1]) + (a1[2] * a1[2] + a1[3] * a1[3])
                         + (b0[0] * b0[0] + b0[1] * b0[1]) + (b0[2] * b0[2] + b0[3] * b0[3]) + (b1[0] * b1[0] + b1[1] * b1[1]) + (b1[2] * b1[2] + b1[3] * b1[3]);
                ss += __shfl_xor(ss, 1); ss += __shfl_xor(ss, 2); ss += __shfl_xor(ss, 4);
                km = fmaxf(km, ss); }
#pragma unroll
            for (int o_ = 8; o_ < 64; o_ <<= 1) { qm = fmaxf(qm, __shfl_xor(qm, o_)); km = fmaxf(km, __shfl_xor(km, o_)); }
            if (lane == 0) { __hip_atomic_fetch_max((unsigned*)(ctl + CW_QKMAX), __builtin_bit_cast(unsigned, qm), RLX_AGENT); __hip_atomic_fetch_max((unsigned*)(ctl + CW_QKMAX + 64), __builtin_bit_cast(unsigned, km), RLX_AGENT); } }
        if (vcu >= G - (NBP + NBS)) {
            LAS float* part = (LAS float*)(lds + RING_OFF);
            const int cw = vcu - (G - (NBP + NBS)); const bool smp = cw >= NBP; const int b = smp ? cw - NBP : cw, h = tid & 7, c = tid >> 3;
            const int L = smp ? 65 : 64, nchunk = smp ? 32 : 64, t0 = c * L;
            const float* lf_new = out + O_LF + (size_t)(smp ? MP + b * TS : b * TP) * NH; const float* lf_old = arg_in(I_CLF) + (size_t)b * PAST * NH;
            float s = 0.f, lmax = -1.f;
            if (c < nchunk) for (int i = 0; i < L; ++i) { const int t = t0 + i; const float v = smp ? (t < PAST ? lf_old[(size_t)t * NH + h] : lf_new[(size_t)(t - PAST) * NH + h]) : lf_new[(size_t)t * NH + h]; s += v; lmax = fmaxf(lmax, v); }
            if (lmax > 0.f) __hip_atomic_fetch_max((unsigned*)(ctl + CW_QKMAX), 0x7f000000u, RLX_AGENT);
            part[c * 8 + h] = s; __syncthreads();
            float run = 0.f; for (int cc = 0; cc < c; ++cc) run += part[cc * 8 + h];
            float* dst = smp ? ncumS + (size_t)(b * NH + h) * SCUM : ncumP + (size_t)(b * NH + h) * TP;
            if (c < nchunk) for (int i = 0; i < L; ++i) { const int t = t0 + i; run += smp ? (t < PAST ? lf_old[(size_t)t * NH + h] : lf_new[(size_t)(t - PAST) * NH + h]) : lf_new[(size_t)t * NH + h]; dst[t] = -run * LOG2E; }
            if (smp && c >= 32 && c < 36) { for (int i = 0; i < 8; ++i) dst[SKV + (c - 32) * 8 + i] = 0.f; }
            __syncthreads();
        }
        }
    SEAM(3);

    if (IN(4)) {
#ifndef NO_MLA
        { const att::Tensors T{Qm, Km, Vm, kr_all, ncumP, ncumS, o_a, (const unsigned*)(ctl + CW_QKMAX), nullptr, nullptr, nullptr, nullptr}; att::attn_phase<false>(T, ctl + CW_QA, lds + RING_OFF, MISC, wave); }
#endif
#ifndef NO_FOX
        { const att::Tensors T{fq, fk_all, fv_all, kr_all, ncumP, ncumS, o_b, (const unsigned*)(ctl + CW_QKMAX), arg_in(I_CFK), arg_in(I_CFV), out + O_FK, out + O_FV}; att::attn_phase<true>(T, ctl + CW_QB, lds + RING_OFF, MISC, wave); }
#endif
    }
#if defined(REPEAT4)
    { if (IN(4)) xcd_barrier(bar);
      { const att::Tensors T{Qm, Km, Vm, kr_all, ncumP, ncumS, o_a, (const unsigned*)(ctl + CW_QKMAX), nullptr, nullptr, nullptr, nullptr}; att::attn_phase<false>(T, ctl + CW_QA + 128, lds + RING_OFF, MISC, wave); }
      { const att::Tensors T{fq, fk_all, fv_all, kr_all, ncumP, ncumS, o_b, (const unsigned*)(ctl + CW_QKMAX), arg_in(I_CFK), arg_in(I_CFV), out + O_FK, out + O_FV}; att::attn_phase<true>(T, ctl + CW_QB + 128, lds + RING_OFF, MISC, wave); } }
#endif
    SEAM(4);

    if (IN(7)) {
        { pg8::Gemm g{o_a, Wt_oa, MT, DM, FW}; TileOrder S; S.init(MT / 256, DM / 256, G, bx, 0); EpiGate<false> E{sga, sga + (size_t)MP * DM, mg};
          pg8::gemm_phase<EpiGate<false>, TileOrder, ALIGN_HEAVY, true>(lds + RING_OFF, g, S, E, wave); }
        { pg8::Gemm g{o_b, Wt_ob, MT, DM, FW}; TileOrder S; S.init(MT / 256, DM / 256, G, bx, 0);
#if defined(DBG_NORAW)
          EpiGate<false> E{sgb, sgb + (size_t)MP * DM, hb};
#else
          EpiGate<true> E{sgb, sgb + (size_t)MP * DM, mg};
#endif
          #if defined(DBG_NORAW)
          pg8::gemm_phase<EpiGate<false>, TileOrder, ALIGN_HEAVY, true>(lds + RING_OFF, g, S, E, wave); }
#else
          pg8::gemm_phase<EpiGate<true>, TileOrder, ALIGN_HEAVY, true>(lds + RING_OFF, g, S, E, wave); }
#endif
    }
    SEAM(7);

    if (IN(8)) {
#define P8_WO() do { pg8::Gemm g{mg, Wt_o, MT, DM, DM}; TileOrder S; S.init(MT / 256, DM / 256, G, bx, 0); EpiRes<0> E{arg_in(I_XP), arg_in(I_XS), out, hb, rss1, nullptr, nullptr}; \
        pg8::gemm_phase<EpiRes<0>, TileOrder, ALIGN_HEAVY, true>(lds + RING_OFF, g, S, E, wave); } while (0)
#define P8_PLE() do { int kple = PLE; asm volatile("" : "+s"(kple)); pg8::Gemm g2{pe_bf, Wt_ple, MT, DM, kple}; TileOrder S2; S2.init(MT / 256, DM / 256, G - 16, bx >= 16 ? bx - 16 : (1 << 28), 0); EpiPle E2{pleo}; \
        pg8::gemm_phase<EpiPle, TileOrder, true, true>(lds + RING_OFF, g2, S2, E2, wave); } while (0)
        if (bx & 1) { P8_PLE(); P8_WO(); } else { P8_WO(); P8_PLE(); }
#undef P8_WO
#undef P8_PLE
    }
    SEAM(8);

    {
        constexpr int ch = 0;
        constexpr int pm0 = ch * CHUNK_TILES, row0 = pm0 * 256;
        if (IN(9 + 3 * ch)) {
            pg8::Gemm g{hb, Wt_up, MT, DFF2, DM}; TileOrder S; S.init(CHUNK_TILES, DFF2 / 256, G, bx, pm0);
            EpiUpAct E{actb, out, rss1, arg_in(I_WCONV), arg_in(I_BCONV), Uh, (LAS unsigned*)(lds + HALO_OFF), row0};
            pg8::gemm_phase<EpiUpAct, TileOrder, true, true>(lds + RING_OFF, g, S, E, wave);
        }
        SEAM(9 + 3 * ch);
        if (IN(11 + 3 * ch)) {
            if (bx & 1) {
                pg8::Gemm gs{hb, Wt_up, MT, DFF2, DM}; TileOrder Ss; Ss.init(MT / 256 - 128, DFF2 / 256, G / 2, bx >> 1, 128);
                EpiUp Es{Ubuf, out, rss1, MP};
                pg8::gemm_phase<EpiUp, TileOrder, true, true>(lds + RING_OFF, gs, Ss, Es, wave);
            }
            pg8::Gemm g{actb - (size_t)row0 * DFF, Wt_dn, MT, DM, DFF}; TileOrder S; S.init(CHUNK_TILES, DM / 256, G, bx, pm0);
                {
                    pg8::Unit fu; const float* wc_ = arg_in(I_WCONV); const float* bc_ = arg_in(I_BCONV);
                    for (int i = 0; S.next(i, fu); ++i) { if ((fu.pm & 15) == 0) continue;
                        const float* u2 = Uh + ((size_t)(fu.pm - 1) * 4 + 2) * DFF2; const float* u0 = Uh + (size_t)fu.pm * 4 * DFF2;
                        for (int j = tid; j < DFF; j += NWAVES * 64) { const int jp = (j >> 7) * 256 + (j & 127);
                            float x[2][4];
#pragma unroll
                            for (int bj = 0; bj < 2; ++bj) { x[bj][0] = u2[jp + bj * 128]; x[bj][1] = u2[DFF2 + jp + bj * 128]; x[bj][2] = u0[jp + bj * 128]; x[bj][3] = u0[DFF2 + jp + bj * 128]; }
#pragma unroll
                            for (int q = 0; q < 2; ++q) { float cvv[2];
#pragma unroll
                                for (int bj = 0; bj < 2; ++bj) { const int col = bj * DFF + j; cvv[bj] = bc_[col] + wc_[col] * x[bj][q] + wc_[DFF2 + col] * x[bj][q + 1] + wc_[2 * DFF2 + col] * x[bj][q + 2]; }
                                const float xg = cvv[1], z = xg + 0.044715f * xg * xg * xg;
                                actb[(size_t)(fu.pm * 256 + q - row0) * DFF + j] = (bf16)f2bf(cvv[0] * xg * __builtin_amdgcn_rcpf(1.f + __builtin_amdgcn_exp2f(-2.f * 0.7978845608028654f * LOG2E * z))); } } }
                    VM_WAIT(); __syncthreads(); }
            EpiRes<1> E{nullptr, nullptr, out, hb2, rss2, nullptr, nullptr};
            pg8::gemm_phase<EpiRes<1>, TileOrder, ALIGN_HEAVY, true>(lds + RING_OFF, g, S, E, wave);
        }
        SEAM(11 + 3 * ch);
    }
    {
        constexpr int ch = NCHUNK - 1, pm0 = ch * CHUNK_TILES, ntile = MT / 256 - pm0, row0 = pm0 * 256, nrows = ntile * 256;
#if defined(REPEAT_ACT)
        for (int repa = 0; repa < 2; ++repa)
#endif
        if (IN(10 + 3 * ch)) {
            const size_t nitem = (size_t)(nrows / 32) * (DFF / 8);
            for (size_t it = gt; it < nitem; it += NT) {
                const int rb = (int)(it / (DFF / 8)), cg = (int)(it % (DFF / 8)), c0 = cg * 8, r0 = row0 + rb * 32;
                f32x4 wv[3][2], wg[3][2], bv[2], bg[2];
#pragma unroll
                for (int k = 0; k < 3; ++k) { const float* w = arg_in(I_WCONV) + (size_t)k * DFF2 + c0; wv[k][0] = *(const f32x4*)w; wv[k][1] = *(const f32x4*)(w + 4); wg[k][0] = *(const f32x4*)(w + DFF); wg[k][1] = *(const f32x4*)(w + DFF + 4); }
                { const float* bb = arg_in(I_BCONV) + c0; bv[0] = *(const f32x4*)bb; bv[1] = *(const f32x4*)(bb + 4); bg[0] = *(const f32x4*)(bb + DFF); bg[1] = *(const f32x4*)(bb + DFF + 4); }
                f32x4 v2[2], v1[2], g2[2], g1[2];
                const bf16* up = Ubuf + (size_t)(r0 - row0) * DFF2 + (c0 >> 7) * 256 + (c0 & 127);
#define GOFF 128
                if (r0 >= MP) { const float* st = arg_in(I_CONV) + (size_t)((r0 - MP) >> 5) * 2 * DFF2 + c0;
                    v2[0] = *(const f32x4*)st; v2[1] = *(const f32x4*)(st + 4); g2[0] = *(const f32x4*)(st + DFF); g2[1] = *(const f32x4*)(st + DFF + 4);
                    v1[0] = *(const f32x4*)(st + DFF2); v1[1] = *(const f32x4*)(st + DFF2 + 4); g1[0] = *(const f32x4*)(st + DFF2 + DFF); g1[1] = *(const f32x4*)(st + DFF2 + DFF + 4); }
                else if ((r0 & (TP - 1)) == 0) { const f32x4 z = {0.f, 0.f, 0.f, 0.f}; v2[0] = v2[1] = v1[0] = v1[1] = g2[0] = g2[1] = g1[0] = g1[1] = z; }
                else { unpack8(*(const v4u*)(up - 2 * DFF2), v2[0], v2[1]); unpack8(*(const v4u*)(up - 2 * DFF2 + GOFF), g2[0], g2[1]); unpack8(*(const v4u*)(up - DFF2), v1[0], v1[1]); unpack8(*(const v4u*)(up - DFF2 + GOFF), g1[0], g1[1]); }
                bf16* ap = actb + (size_t)(r0 - row0) * DFF + c0;
#pragma unroll 8
                for (int r = 0; r < 32; ++r) {
                    f32x4 v0[2], g0[2]; unpack8(*(const v4u*)(up + (size_t)r * DFF2), v0[0], v0[1]); unpack8(*(const v4u*)(up + (size_t)r * DFF2 + GOFF), g0[0], g0[1]);
                    f32x4 o[2];
#pragma unroll
                    for (int q = 0; q < 2; ++q) { const f32x4 cv = bv[q] + wv[0][q] * v2[q] + wv[1][q] * v1[q] + wv[2][q] * v0[q], cgt = bg[q] + wg[0][q] * g2[q] + wg[1][q] * g1[q] + wg[2][q] * g0[q];
#pragma unroll
                        for (int k = 0; k < 4; ++k) { const float x = cgt[k]; const float z = x + 0.044715f * x * x * x;
                            o[q][k] = cv[k] * x * __builtin_amdgcn_rcpf(1.f + __builtin_amdgcn_exp2f(-2.f * 0.7978845608028654f * LOG2E * z)); }
                        v2[q] = v1[q]; v1[q] = v0[q]; g2[q] = g1[q]; g1[q] = g0[q]; }
                    *(v4u*)(ap + (size_t)r * DFF) = pack8(o[0], o[1]);
                }
            }
        }
        SEAM(10 + 3 * ch);
        if (IN(11 + 3 * ch)) {
            pg8::Gemm g{actb - (size_t)row0 * DFF, Wt_dn, MT, DM, DFF / KSPLIT, DFF}; SplitKOrder S; S.init(G, bx);
            EpiSlab E{slab};
            pg8::gemm_phase<EpiSlab, SplitKOrder, true, true>(lds + RING_OFF, g, S, E, wave);
        }
        SEAM(11 + 3 * ch);
    }

    if (IN(18)) {
        for (int r = gw; r < MS; r += NGW) { const int row = MP + r; float* hp = out + (size_t)row * DM + 4 * lane; f32x4 v[8]; float ss = 0.f;
#pragma unroll
            for (int j = 0; j < 8; ++j) { v[j] = *(const f32x4*)(hp + 256 * j);
#pragma unroll
                for (int ks = 0; ks < KSPLIT; ++ks) v[j] += *(const f32x4*)(slab + ((size_t)ks * MS + r) * DM + 4 * lane + 256 * j);
                ss += (v[j][0] * v[j][0] + v[j][1] * v[j][1]) + (v[j][2] * v[j][2] + v[j][3] * v[j][3]); }
            ss = wave_sum(ss);
#pragma unroll
            for (int j = 0; j < 8; ++j) { *(f32x4*)(hp + 256 * j) = v[j]; *(v2u*)(hb2 + (size_t)row * DM + 4 * lane + 256 * j) = pack4(v[j]); }
            if (lane == 0) rss2[row] = ss; }
    }
    SEAM(18);
    if (IN(19)) {
        pg8::Gemm g{hb2, Wt_pg, MT, DM, DM}; TileOrder S; S.init(MT / 256, DM / 256, G, bx, 0);
        EpiRes<2> E{nullptr, nullptr, out, nullptr, rss3, rss2, pleo};
        pg8::gemm_phase<EpiRes<2>, TileOrder, ALIGN_HEAVY, true>(lds + RING_OFF, g, S, E, wave);
    }
    SEAM(19);
#if defined(DBG_DUMP)
    if (lo <= 20 && 20 < hi) {
        for (size_t e = gt; e < (size_t)MT * DM / 8; e += NT) { const size_t e8 = e * 8; const int row = (int)(e8 / DM), c = (int)(e8 % DM);
            f32x4 a, b;
#if DBG_DUMP == 1
            unpack8(*(const v4u*)((c < 1024 ? o_a : o_b) + (size_t)row * 1024 + (c & 1023)), a, b);
#elif DBG_DUMP == 2
            unpack8(*(const v4u*)(mg + e8), a, b);
#if defined(DBG_NORAW)
            { f32x4 a2, b2; unpack8(*(const v4u*)(hb + e8), a2, b2); a += a2; b += b2; }
#endif
#elif DBG_DUMP == 6
            unpack8(*(const v4u*)(sga + e8), a, b);
#elif DBG_DUMP == 7
            unpack8(*(const v4u*)(sgb + e8), a, b);
#elif DBG_DUMP == 8
            unpack8(*(const v4u*)(A0b + e8), a, b);
#elif DBG_DUMP == 9
            unpack8(*(const v4u*)(Wt_in + (size_t)4352 * DM + (e8 % ((size_t)4096 * DM))), a, b);
#elif DBG_DUMP == 3
            unpack8(*(const v4u*)(hb + e8), a, b);
#elif DBG_DUMP == 4
            if (c < 512) unpack8(*(const v4u*)(cqn + (size_t)row * 512 + c), a, b); else if (c < 1536) unpack8(*(const v4u*)(fq + (size_t)row * 1024 + (c - 512)), a, b); else unpack8(*(const v4u*)(pe_bf + (size_t)row * 256 + ((c - 1536) & 255)), a, b);
#elif DBG_DUMP == 5
            if (c < 1536) unpack8(*(const v4u*)(Qm + (size_t)row * 1536 + c), a, b); else unpack8(*(const v4u*)(Km + (size_t)row * 1024 + (c - 1536)), a, b);
#endif
            *(f32x4*)(out + e8) = a; *(f32x4*)(out + e8 + 4) = b; }
#if !defined(DBG_KEEP_CONV)
        for (size_t e = gt; e < (O_END - O_CVP); e += NT) out[O_CVP + e] = 0.f;
#endif
    }
#else
    if (IN(20)) {
        for (int row = gw; row < MT; row += NGW) {
            float* p = out + (size_t)row * DM + 4 * lane; const float rs = 1.f / sqrtf(rss3[row] * (1.f / DM) + EPS);
#pragma unroll
            for (int j = 0; j < 8; ++j) { const f32x4 v = *(const f32x4*)(p + 256 * j), g = *(const f32x4*)(arg_in(I_GFIN) + 4 * lane + 256 * j); *(f32x4*)(p + 256 * j) = v * rs * g; }
        }
    }
#endif
#undef IN
#undef SEAM
}

#undef tid
#undef lane
#undef gw
#undef NGW
#undef gt
#undef NT
#ifndef MK_PER_PHASE
#define MK_PER_PHASE 0
#endif
extern "C" void kernel_launch(void* const* d_in, const int* in_sizes, int n_in, void* d_out, int out_size, void* d_ws, size_t ws_size, hipStream_t stream) {
    static int grid = 0;
    if (grid == 0) {
        if (n_in != 29 || in_sizes[0] != MP * DM || (size_t)out_size != O_END || ws_size < WS_END) {
            fprintf(stderr, "kernel_launch: shape mismatch: n_in %d in0 %d out %d ws %zu (need %zu)\n", n_in, n_in > 0 ? in_sizes[0] : -1, out_size, ws_size, (size_t)WS_END); grid = -1; return; }
        int dev = 0, cus = 0, per_cu = 0;
        if (hipGetDevice(&dev) != hipSuccess || hipDeviceGetAttribute(&cus, hipDeviceAttributeMultiprocessorCount, dev) != hipSuccess) { grid = -1; return; }
        if (hipFuncSetAttribute((const void*)mega_fwd, hipFuncAttributeMaxDynamicSharedMemorySize, LDS_BYTES) != hipSuccess) { fprintf(stderr, "kernel_launch: hipFuncSetAttribute failed\n"); grid = -1; return; }
        if (hipOccupancyMaxActiveBlocksPerMultiprocessor(&per_cu, (const void*)mega_fwd, NWAVES * 64, LDS_BYTES) != hipSuccess || per_cu < 1)
            fprintf(stderr, "kernel_launch: note: occupancy query reports %d workgroups per CU\n", per_cu);
        (void)hipGetLastError();
        grid = cus;
    }
    if (grid < 0) return;
    if (hipMemsetAsync((char*)d_ws + WS_CTL, 0, CTL_ZERO_BYTES, stream) != hipSuccess) { fprintf(stderr, "kernel_launch: memset failed\n"); return; }
    Args a{};
    for (int i = 0; i < 29; ++i) a.in[i] = (const float*)d_in[i];
    a.out = (float*)d_out; a.ws = (unsigned char*)d_ws;
#if MK_PER_PHASE
    for (int p = 0; p < NPHASE; ++p) { a.ph_lo = p; a.ph_hi = p + 1; hipLaunchKernelGGL(mega_fwd, dim3(grid), dim3(NWAVES * 64), LDS_BYTES, stream, a); }
#else
    a.ph_lo = 0; a.ph_hi = NPHASE;
    hipLaunchKernelGGL(mega_fwd, dim3(grid), dim3(NWAVES * 64), LDS_BYTES, stream, a);
#endif
    const hipError_t le = hipPeekAtLastError();
    if (le != hipSuccess) fprintf(stderr, "kernel_launch: launch failed: %s\n", hipGetErrorName(le));
}
```

```cpp
#include <hip/hip_runtime.h>
#include <cstdio>
#include <cstdint>
__device__ __forceinline__ int lane_id_nv() { int l; asm volatile("v_mbcnt_lo_u32_b32 %0, -1, 0\n\tv_mbcnt_hi_u32_b32 %0, -1, %0" : "=v"(l)); return l; }
namespace pg8 {
#define PG8_LAS __attribute__((address_space(3)))
typedef unsigned short bf16_t;
typedef short bf16x8 __attribute__((ext_vector_type(8)));
typedef float f32x4 __attribute__((ext_vector_type(4)));
typedef unsigned u32x4 __attribute__((ext_vector_type(4)));
constexpr int BM = 256, BK = 64, HALF = 128, HTB = HALF * BK * 2  , STAGE_BYTES = 8 * HTB, NXCD = 8, WGM = 8;

__host__ __device__ __forceinline__ int lds_byte(int r, int c) { const int st = (r >> 4) * 2 + (c >> 5), rr = r & 15, cc = c & 31, ob = rr * 64 + cc * 2; return st * 1024 + (ob ^ (((ob >> 9) & 1) << 5)); }
__host__ __device__ __forceinline__ void stage_rc(int b, int& R, int& C) { const int st = b / 1024, sb = b % 1024, swz = sb ^ (((sb >> 9) & 1) << 5); R = (st >> 1) * 16 + swz / 64; C = (st & 1) * 32 + (swz % 64) / 2; }
__host__ __device__ __forceinline__ int perm32(int rho) { const int n = rho >> 4, i = rho & 15; return 8 * (i >> 2) + 4 * n + (i & 3); }

struct Unit { int pm, pn, kb; };
struct Gemm { const bf16_t* A; const bf16_t* Bt; int M, N, K, ld; };

struct StaticOrder {
    int nM, nN, nwg, G, c;
    __host__ __device__ void init(int M, int N, int G_, int c_) { nM = M / BM; nN = N / BM; nwg = nM * nN; G = G_; c = c_; }
    __host__ __device__ bool next(int i, Unit& u) const {
        const long L = (long)i * G + c; if (L >= nwg) return false;
        int wgid = (int)L; { const int q = nwg / NXCD, r = nwg % NXCD, xcd = wgid % NXCD, off = wgid / NXCD; wgid = (xcd < r ? xcd * (q + 1) : r * (q + 1) + (xcd - r) * q) + off; }
        const int nig = WGM * nN, gid = wgid / nig, fm = gid * WGM, gsz = (nM - fm) < WGM ? (nM - fm) : WGM;
        u.pm = fm + ((wgid % nig) % gsz); u.pn = (wgid % nig) / gsz; return true;
    }
    __device__ __forceinline__ void a_ready(const Unit&) const {}
    __device__ __forceinline__ void done(const Unit&) const {}
};
__device__ __forceinline__ unsigned cvt_pk_bf16(float lo, float hi) { unsigned r; asm volatile("v_cvt_pk_bf16_f32 %0, %1, %2" : "=v"(r) : "v"(lo), "v"(hi)); return r; }
template <class Epi, class Sched, bool ALIGN_EPI = false, bool SP2 = false>
__device__ __forceinline__ void gemm_phase(PG8_LAS unsigned char* lds, const Gemm g, const Sched& S, const Epi& E, const int wave_id) {
    int tid_ = wave_id * 64 + lane_id_nv(); asm volatile("" : "+v"(tid_));
    const int tid = tid_, wid = __builtin_amdgcn_readfirstlane(tid >> 6), lane = tid & 63, wr = wid >> 2, wc = wid & 3, fr = lane & 15, fq = lane >> 4;
    const int K = g.K, nt = K / BK, ld = g.ld ? g.ld : g.K;
    unsigned voffA[2], voffB[2];
#pragma unroll
    for (int i = 0; i < 2; ++i) { int R, C; stage_rc(tid * 16 + i * 8192, R, C); const int Rb = Epi::PERM ? ((R & ~31) + perm32(R & 31)) : R;
        voffA[i] = (unsigned)(R * ld + C) * 2u; voffB[i] = (unsigned)(Rb * ld + C) * 2u; }
    const size_t kstep = (size_t)(BK * 2);
    const size_t hstep = (size_t)HALF * ld * 2;
    const size_t tstep = 2 * hstep;
    const unsigned ldsw = (unsigned)wid * 1024u;
    const int aoff = lds_byte(wr * 64 + fr, fq * 8), boff = lds_byte(wc * 32 + fr, fq * 8);
#define PG8_SA(b, h) (((b) * 2 + (h)) * HTB)
#define PG8_SB(b, h) ((4 + (b) * 2 + (h)) * HTB)
#define PG8_STAGE(bufoff, gbase, voff) do { _Pragma("unroll") for (int _i = 0; _i < 2; ++_i) \
        __builtin_amdgcn_global_load_lds((const unsigned*)((const char*)(gbase) + (voff)[_i]), (PG8_LAS unsigned*)(lds + (bufoff) + ldsw + _i * 8192), 16, 0, 0); } while (0)
#define PG8_LDA(dst, b, h) do { _Pragma("unroll") for (int m = 0; m < 4; ++m) _Pragma("unroll") for (int k = 0; k < 2; ++k) dst[m][k] = *(const PG8_LAS bf16x8*)(lds + PG8_SA(b, h) + aoff + m * 2048 + k * 1024); } while (0)
#define PG8_LDB(dst, b, h) do { _Pragma("unroll") for (int n = 0; n < 2; ++n) _Pragma("unroll") for (int k = 0; k < 2; ++k) dst[n][k] = *(const PG8_LAS bf16x8*)(lds + PG8_SB(b, h) + boff + n * 2048 + k * 1024); } while (0)
#define PG8_MMA(ai, bj, At, Bt) do { __builtin_amdgcn_s_setprio(1); _Pragma("unroll") for (int m = 0; m < 4; ++m) _Pragma("unroll") for (int n = 0; n < 2; ++n) _Pragma("unroll") for (int k = 0; k < 2; ++k) \
        acc[ai][bj][m][n] = __builtin_amdgcn_mfma_f32_16x16x32_bf16(Bt[n][k], At[m][k], acc[ai][bj][m][n], 0, 0, 0); __builtin_amdgcn_s_setprio(0); } while (0)
#define PG8_WAIT_V(n) asm volatile("s_waitcnt vmcnt(" #n ")" ::: "memory")
#define PG8_WAIT_L(n) asm volatile("s_waitcnt lgkmcnt(" #n ")" ::: "memory")
#define PG8_BAR __builtin_amdgcn_s_barrier()
#define PG8_SCHED __builtin_amdgcn_sched_barrier(0)
    Unit cur, nxt; int ui = 0;
    if (!S.next(0, cur)) return;
    f32x4 acc[2][2][4][2];
#pragma unroll
    for (int a = 0; a < 2; ++a)
#pragma unroll
        for (int b = 0; b < 2; ++b)
#pragma unroll
            for (int m = 0; m < 4; ++m)
#pragma unroll
                for (int n = 0; n < 2; ++n) acc[a][b][m][n] = (f32x4){0.f, 0.f, 0.f, 0.f};
    bf16x8 At[4][2], B0[2][2], B1[2][2];
    const char* cA = (const char*)g.A + (size_t)cur.pm * tstep + cur.kb; const char* cB = (const char*)g.Bt + (size_t)cur.pn * tstep + cur.kb;
    S.a_ready(cur);
    if constexpr (SP2) {
        PG8_STAGE(PG8_SB(0, 0), cB, voffB); PG8_STAGE(PG8_SB(0, 1), cB + hstep, voffB); PG8_STAGE(PG8_SA(0, 0), cA, voffA); PG8_STAGE(PG8_SA(0, 1), cA + hstep, voffA);
        if (wr == 1) PG8_BAR;
        PG8_WAIT_V(2); PG8_BAR;
        PG8_STAGE(PG8_SB(1, 0), cB + kstep, voffB); PG8_STAGE(PG8_SA(1, 0), cA + kstep, voffA); PG8_STAGE(PG8_SB(1, 1), cB + hstep + kstep, voffB);
        PG8_WAIT_V(6); PG8_BAR;
    } else {
        PG8_STAGE(PG8_SB(0, 0), cB, voffB); PG8_STAGE(PG8_SA(0, 0), cA, voffA); PG8_STAGE(PG8_SB(0, 1), cB + hstep, voffB); PG8_STAGE(PG8_SA(0, 1), cA + hstep, voffA);
        if (wr == 1) PG8_BAR;
        PG8_WAIT_V(4); PG8_BAR;
        PG8_STAGE(PG8_SB(1, 0), cB + kstep, voffB); PG8_STAGE(PG8_SA(1, 0), cA + kstep, voffA); PG8_STAGE(PG8_SB(1, 1), cB + hstep + kstep, voffB);
        PG8_WAIT_V(6); PG8_BAR;
    }
    for (;;) {
        const bool has_next = S.next(ui + 1, nxt);
        const char* nA = has_next ? (const char*)g.A + (size_t)nxt.pm * tstep + nxt.kb : cA; const char* nB = has_next ? (const char*)g.Bt + (size_t)nxt.pn * tstep + nxt.kb : cB;
        for (int t = 0; t < nt; t += 2) {
            const bool last = (t == nt - 2);
            const char* a1 = cA + (size_t)(t + 1) * kstep;
            const char* a2 = last ? nA : cA + (size_t)(t + 2) * kstep; const char* b2 = last ? nB : cB + (size_t)(t + 2) * kstep;
            const char* a3 = a2 + kstep; const char* b3 = b2 + kstep;
            if (last && has_next) S.a_ready(nxt);
            if constexpr (SP2) {
            PG8_LDB(B0, 0, 0); PG8_LDB(B1, 0, 1); PG8_SCHED; PG8_LDA(At, 0, 0); PG8_STAGE(PG8_SA(1, 1), a1 + hstep, voffA);
            PG8_WAIT_V(8); PG8_WAIT_L(0); PG8_BAR; PG8_MMA(0, 0, At, B0); PG8_MMA(0, 1, At, B1); PG8_BAR; PG8_SCHED;
            PG8_LDA(At, 0, 1); PG8_STAGE(PG8_SB(0, 0), b2, voffB); PG8_STAGE(PG8_SB(0, 1), b2 + hstep, voffB); PG8_STAGE(PG8_SA(0, 0), a2, voffA);
            PG8_WAIT_V(8); PG8_WAIT_L(0); PG8_BAR; PG8_MMA(1, 0, At, B0); PG8_MMA(1, 1, At, B1); PG8_BAR; PG8_SCHED;
            PG8_LDB(B0, 1, 0); PG8_LDB(B1, 1, 1); PG8_SCHED; PG8_LDA(At, 1, 0); PG8_STAGE(PG8_SA(0, 1), a2 + hstep, voffA);
            PG8_WAIT_V(8); PG8_WAIT_L(0); PG8_BAR; PG8_MMA(0, 0, At, B0); PG8_MMA(0, 1, At, B1); PG8_BAR; PG8_SCHED;
            PG8_LDA(At, 1, 1); PG8_STAGE(PG8_SB(1, 0), b3, voffB); PG8_STAGE(PG8_SB(1, 1), b3 + hstep, voffB); PG8_STAGE(PG8_SA(1, 0), a3, voffA);
            PG8_WAIT_V(8); PG8_WAIT_L(0); PG8_BAR; PG8_MMA(1, 0, At, B0); PG8_MMA(1, 1, At, B1); PG8_BAR; PG8_SCHED;
            } else {
            PG8_LDB(B0, 0, 0); PG8_SCHED; PG8_LDA(At, 0, 0); PG8_STAGE(PG8_SA(1, 1), a1 + hstep, voffA);
            PG8_WAIT_L(8); PG8_BAR; PG8_WAIT_L(0); PG8_MMA(0, 0, At, B0); PG8_BAR; PG8_SCHED;
            PG8_LDB(B1, 0, 1); PG8_STAGE(PG8_SB(0, 0), b2, voffB);
            PG8_BAR; PG8_WAIT_L(0); PG8_MMA(0, 1, At, B1); PG8_BAR;
            PG8_LDA(At, 0, 1); PG8_STAGE(PG8_SA(0, 0), a2, voffA);
            PG8_BAR; PG8_WAIT_L(0); PG8_MMA(1, 0, At, B0); PG8_BAR; PG8_SCHED;
            PG8_STAGE(PG8_SB(0, 1), b2 + hstep, voffB);
            PG8_WAIT_V(6); PG8_BAR; PG8_MMA(1, 1, At, B1); PG8_BAR;
            PG8_LDB(B0, 1, 0); PG8_SCHED; PG8_LDA(At, 1, 0); PG8_STAGE(PG8_SA(0, 1), a2 + hstep, voffA);
            PG8_WAIT_L(8); PG8_BAR; PG8_WAIT_L(0); PG8_MMA(0, 0, At, B0); PG8_BAR; PG8_SCHED;
            PG8_LDB(B1, 1, 1); PG8_STAGE(PG8_SB(1, 0), b3, voffB);
            PG8_BAR; PG8_WAIT_L(0); PG8_MMA(0, 1, At, B1); PG8_BAR;
            PG8_LDA(At, 1, 1); PG8_STAGE(PG8_SA(1, 0), a3, voffA);
            PG8_BAR; PG8_WAIT_L(0); PG8_MMA(1, 0, At, B0); PG8_BAR; PG8_SCHED;
            PG8_STAGE(PG8_SB(1, 1), b3 + hstep, voffB);
            PG8_WAIT_V(6); PG8_BAR; PG8_MMA(1, 1, At, B1); PG8_BAR;
            }
        }
        if constexpr (ALIGN_EPI) { if (wr == 0) PG8_BAR; }
        if constexpr (!Epi::AFTER_DRAIN) { E(acc, cur, wr, wc, fr, fq); S.done(cur); }
        if (!has_next) break;
#pragma unroll
        for (int a = 0; a < 2; ++a)
#pragma unroll
            for (int b = 0; b < 2; ++b)
#pragma unroll
                for (int m = 0; m < 4; ++m)
#pragma unroll
                    for (int n = 0; n < 2; ++n) acc[a][b][m][n] = (f32x4){0.f, 0.f, 0.f, 0.f};
        cur = nxt; cA = nA; cB = nB; ++ui;
        if constexpr (ALIGN_EPI) { if (wr == 1) PG8_BAR; }
    }
    PG8_WAIT_V(0);
    if constexpr (!ALIGN_EPI) { if (wr == 0) PG8_BAR; }
    PG8_BAR;
    if constexpr (Epi::AFTER_DRAIN) { E.fused(acc, cur, wr, wc, fr, fq, lds, wid, lane); S.done(cur); }
#undef PG8_SA
#undef PG8_SB
#undef PG8_STAGE
#undef PG8_LDA
#undef PG8_LDB
#undef PG8_MMA
#undef PG8_WAIT_V
#undef PG8_WAIT_L
#undef PG8_BAR
#undef PG8_SCHED
}
}

constexpr int NWAVES = 8;
constexpr int DM = 2048, MP = 32768, MS = 512, MT = MP + MS;
constexpr int TP = 4096, NBP = 8, NBS = 16, TS = 32, PAST = 2048, SKV = PAST + TS;
constexpr int RKV = MP + NBS * SKV, RKV_PAD = RKV + 64;
constexpr int QR = 512, KVR = 512, ROPE = 64, NH = 8, HD = 128, FW = 1024, DFF = 5632, DFF2 = 11264, PLE = 256;
constexpr int INW = 8264, NIN = 8448;
constexpr int NQ = 1536, NKV = 2048, SCUM = 2112;
constexpr float EPS = 1e-6f, LOG2E = 1.4426950408889634f;
constexpr float MLA_C2 = 0.07216878364870322f * LOG2E, FOX_C2 = 0.08838834764831845f * LOG2E;
constexpr int KSPLIT = 11;
constexpr int CHUNK_TILES = 128, NCHUNK = 2;
constexpr int NPHASE = 9 + 3 * 3 + 3;

constexpr size_t O_Y = 0, O_CKV = (size_t)MT * DM, O_KR = O_CKV + (size_t)MT * KVR, O_FK = O_KR + (size_t)MT * ROPE, O_FV = O_FK + (size_t)MT * FW,
                 O_LF = O_FV + (size_t)MT * FW, O_CVP = O_LF + (size_t)MT * NH, O_CVS = O_CVP + (size_t)NBP * 2 * DFF2, O_END = O_CVS + (size_t)NBS * 2 * DFF2;
static_assert(O_END == 156291072ull, "d_out size");

constexpr size_t MiB = 1u << 20;
constexpr size_t WS_CTL = 0, CTL_ZERO_BYTES = 1 * MiB;
constexpr size_t WS_ROPE = 1 * MiB, WS_NCUMP = 2 * MiB, WS_NCUMS = 3 * MiB, WS_RSS = 5 * MiB, WS_PE = 6 * MiB, WS_KR = 23 * MiB;
constexpr size_t WS_WIN = 32 * MiB, WS_WUQ = 65 * MiB, WS_WUKV = WS_WUQ + 3 * MiB / 2, WS_WOA = WS_WUKV + 2 * MiB, WS_WOB = WS_WOA + 4 * MiB, WS_WO = WS_WOB + 4 * MiB,
                 WS_WUP = WS_WO + 8 * MiB, WS_WDN = WS_WUP + 44 * MiB, WS_WPG = WS_WDN + 22 * MiB, WS_WPLE = WS_WPG + 8 * MiB;
constexpr size_t WS_D = 160 * MiB;
static_assert(WS_WPLE + 1 * MiB <= WS_D, "weights fit");
constexpr size_t WS_FK = WS_D, WS_FV = WS_D + 130 * MiB, WS_FQ = WS_D + 260 * MiB, WS_CKV = WS_D + 325 * MiB, WS_CQN = WS_D + 390 * MiB, WS_QM = WS_D + 423 * MiB,
                 WS_KM = WS_D + 521 * MiB, WS_VM = WS_D + 651 * MiB, WS_A0 = WS_D + 521 * MiB, WS_CQR = WS_D + 651 * MiB, WS_OA = WS_D + 325 * MiB, WS_OB = WS_D + 781 * MiB,
                 WS_A0B = WS_D, WS_SGA = WS_D + 130 * MiB, WS_SGB = WS_D + 650 * MiB, WS_SGS = WS_D + 846 * MiB, WS_SLAB = WS_D + 528 * MiB, WS_UH = WS_D + 482 * MiB, WS_MG = WS_D + 455 * MiB, WS_HB = WS_D + 585 * MiB, WS_U = WS_D + 572 * MiB, WS_ACT = WS_D + 130 * MiB, WS_HB2 = WS_D + 715 * MiB, WS_PLEO = WS_D, WS_END = 1024 * MiB;
static_assert((size_t)RKV_PAD * 1024 * 2 <= 130 * MiB && (size_t)MT * NQ * 2 <= 98 * MiB && WS_OB + 65 * MiB <= WS_END && WS_HB2 + 130 * MiB <= WS_END, "d_ws map");
constexpr int CW_QA = 64, CW_QB = 128, CW_QKMAX = 320;
constexpr int CW_BAR = 4096;
constexpr int RING_OFF = 0, RING_BYTES = 131072, LDSCTL_OFF = RING_BYTES, MISC_OFF = LDSCTL_OFF + 320, HALO_OFF = LDSCTL_OFF + 2048, LDS_BYTES = 147456;

#define GAS __attribute__((address_space(1)))
#define LAS __attribute__((address_space(3)))
typedef unsigned short bf16;
typedef unsigned v4u __attribute__((ext_vector_type(4)));
typedef unsigned v2u __attribute__((ext_vector_type(2)));
typedef float f32x4 __attribute__((ext_vector_type(4)));
typedef float f32x16 __attribute__((ext_vector_type(16)));
typedef short bf16x8 __attribute__((ext_vector_type(8)));
typedef short s16x4 __attribute__((ext_vector_type(4)));
typedef GAS unsigned gu32;
#define RLX_AGENT __ATOMIC_RELAXED, __HIP_MEMORY_SCOPE_AGENT
#define LDS_WAIT() asm volatile("s_waitcnt lgkmcnt(0)" ::: "memory")
#define VM_WAIT() asm volatile("s_waitcnt vmcnt(0)" ::: "memory")
__device__ __forceinline__ unsigned f2bf(float f) { unsigned u = __builtin_bit_cast(unsigned, f); return (u + 0x7fffu + ((u >> 16) & 1u)) >> 16; }
typedef float f32x2_t __attribute__((ext_vector_type(2)));
typedef __bf16 bf16x2_t __attribute__((ext_vector_type(2)));
__device__ __forceinline__ unsigned pk2(float lo, float hi) { f32x2_t v = {lo, hi}; bf16x2_t b = __builtin_convertvector(v, bf16x2_t); return __builtin_bit_cast(unsigned, b); }
__device__ __forceinline__ float bf2f(unsigned short b) { return __builtin_bit_cast(float, (unsigned)b << 16); }
__device__ __forceinline__ v4u pack8(f32x4 a, f32x4 b) { v4u w; w.x = pk2(a[0], a[1]); w.y = pk2(a[2], a[3]); w.z = pk2(b[0], b[1]); w.w = pk2(b[2], b[3]); return w; }
__device__ __forceinline__ v2u pack4(f32x4 a) { v2u w; w.x = pk2(a[0], a[1]); w.y = pk2(a[2], a[3]); return w; }
__device__ __forceinline__ void unpack8(v4u w, f32x4& a, f32x4& b) {
    a[0] = __builtin_bit_cast(float, w.x << 16); a[1] = __builtin_bit_cast(float, w.x & 0xffff0000u); a[2] = __builtin_bit_cast(float, w.y << 16); a[3] = __builtin_bit_cast(float, w.y & 0xffff0000u);
    b[0] = __builtin_bit_cast(float, w.z << 16); b[1] = __builtin_bit_cast(float, w.z & 0xffff0000u); b[2] = __builtin_bit_cast(float, w.w << 16); b[3] = __builtin_bit_cast(float, w.w & 0xffff0000u); }
__device__ __forceinline__ float sigmoidf_(float x) { return __builtin_amdgcn_rcpf(1.f + __builtin_amdgcn_exp2f(-x * LOG2E)); }
__device__ __forceinline__ f32x4 sigmoid4(f32x4 v) { f32x4 o; o[0] = sigmoidf_(v[0]); o[1] = sigmoidf_(v[1]); o[2] = sigmoidf_(v[2]); o[3] = sigmoidf_(v[3]); return o; }
__device__ __forceinline__ int kvrow_of(int row) { if (row < MP) return row; const int s = row - MP; return MP + (s >> 5) * SKV + PAST + (s & 31); }
__device__ __forceinline__ int pos_of(int row) { return row < MP ? (row & (TP - 1)) : PAST + ((row - MP) & 31); }
__device__ __forceinline__ float wave_sum(float v) {
#pragma unroll
    for (int o = 1; o < 64; o <<= 1) v += __shfl_xor(v, o);
    return v;
}
#define XB_TMO      128
#define XB_XCNT(j)  (256  + 64 * (j))
#define XB_XSUB(j)  (1280 + 64 * (j))
#define XB_XGEN(j)  (2304 + 64 * (j))
#define XB_TOP      3328
#define XB_TOPGEN   3392
#define XCD_BAR_WORDS 3456
#define XB_SPIN_CAP (1u << 18)

__device__ __forceinline__ unsigned xb_ld(unsigned* p)              { return __hip_atomic_load(p, __ATOMIC_RELAXED, __HIP_MEMORY_SCOPE_AGENT); }
__device__ __forceinline__ unsigned xb_add(unsigned* p, unsigned v) { return __hip_atomic_fetch_add(p, v, __ATOMIC_RELAXED, __HIP_MEMORY_SCOPE_AGENT); }
__device__ __forceinline__ unsigned xb_xcc_id() { return (unsigned)__builtin_amdgcn_s_getreg((3 << 11) | 20) & 0xFu; }
#define XB_SPIN(cond, bar) do { unsigned _sp = 0; while (cond) { __builtin_amdgcn_s_sleep(1); \
    if ((++_sp & 255u) == 0u) { if (xb_ld(&(bar)[XB_TMO])) break; if (_sp > XB_SPIN_CAP) { atomicAdd(&(bar)[XB_TMO], 1u); break; } } } } while (0)

struct XcdBarrier {
    unsigned* bar; unsigned x; unsigned wv;
    volatile LAS unsigned* st;
};

__device__ __forceinline__ XcdBarrier xcd_barrier_post(unsigned* bar, volatile LAS unsigned* st) {
    XcdBarrier b; b.bar = bar; b.x = xb_xcc_id(); b.st = st; b.wv = (unsigned)__builtin_amdgcn_readfirstlane(threadIdx.x >> 6);
    if (threadIdx.x == 0) (void)xb_add(&bar[XB_XCNT(b.x)], 1u);
    return b;
}
__device__ __forceinline__ void xcd_barrier_complete(unsigned* bar, unsigned x, unsigned& nloc, unsigned& nx) {
    const unsigned G = gridDim.x * gridDim.y * gridDim.z;
    unsigned sum, cnt, mine, sp = 0u;
    for (;;) {
        sum = 0u; cnt = 0u; mine = 0u;
#pragma unroll
        for (unsigned j = 0; j < 16; ++j) { const unsigned c = xb_ld(&bar[XB_XCNT(j)]); sum += c; cnt += (c > 0u) ? 1u : 0u; mine = (j == x) ? c : mine; }
        if (sum == G) break;
        __builtin_amdgcn_s_sleep(1);
        if ((++sp & 255u) == 0u) { if (xb_ld(&bar[XB_TMO])) break; if (sp > XB_SPIN_CAP) { atomicAdd(&bar[XB_TMO], 1u); break; } }
    }
    nloc = mine > 0u ? mine : 1u; nx = cnt > 0u ? cnt : 1u;
}

__device__ __forceinline__ void xcd_barrier(const XcdBarrier& b) {
    asm volatile("s_waitcnt vmcnt(0)" ::: "memory");
    __syncthreads();
    if (b.wv == 0u && (unsigned)lane_id_nv() == 0u) {
        gu32* barg = (gu32*)b.bar; asm volatile("" : "+s"(barg)); unsigned* bar = (unsigned*)barg;
        __builtin_amdgcn_s_waitcnt(0);
        unsigned nloc = b.st[0], nx = b.st[1];
        if (nloc == 0u) { xcd_barrier_complete(bar, b.x, nloc, nx); b.st[0] = nloc; b.st[1] = nx; }
        const unsigned old = xb_add(&bar[XB_XSUB(b.x)], 1u);
        const unsigned gen = old / nloc;
        if (old + 1u == (gen + 1u) * nloc) {
            __builtin_amdgcn_fence(__ATOMIC_RELEASE, "agent");
            asm volatile("s_waitcnt vmcnt(0)" ::: "memory");
            const unsigned og = xb_add(&bar[XB_TOP], 1u);
            const unsigned tg = og / nx;
            if (og + 1u == (tg + 1u) * nx) xb_add(&bar[XB_TOPGEN], 1u);
            else XB_SPIN(xb_ld(&bar[XB_TOPGEN]) == tg, bar);
            __builtin_amdgcn_fence(__ATOMIC_ACQUIRE, "agent");
            xb_add(&bar[XB_XGEN(b.x)], 1u);
            asm volatile("s_waitcnt vmcnt(0)" ::: "memory");
        } else {
            XB_SPIN(xb_ld(&bar[XB_XGEN(b.x)]) == gen, bar);
            __builtin_amdgcn_fence(__ATOMIC_ACQUIRE, "agent");
            asm volatile("s_waitcnt vmcnt(0)" ::: "memory");
        }
    }
    __syncthreads();
}

struct TileOrder {
    pg8::StaticOrder s; int pm0;
    __device__ __forceinline__ void init(int nM, int nN, int G, int c, int pm0_) { s.init(nM * 256, nN * 256, G, c); pm0 = pm0_; }
    __device__ __forceinline__ bool next(int i, pg8::Unit& u) const { if (!s.next(i, u)) return false; u.pm += pm0; u.kb = 0; return true; }
    __device__ __forceinline__ void a_ready(const pg8::Unit&) const {}
    __device__ __forceinline__ void done(const pg8::Unit&) const {}
};

struct P1Order {
    TileOrder t; int G, c;
    __device__ __forceinline__ void init(int G_, int c_) { t.init(MT / 256, 17, G_, c_, 0); G = G_; c = c_; }
    __device__ __forceinline__ bool next(int i, pg8::Unit& u) const { if (t.next(i, u)) return true; const int e = i * G + c - (MT / 256) * 17; if (e < 0 || e >= 32) return false; u.pm = 128 + (e & 1); u.pn = 17 + (e >> 1); u.kb = 0; return true; }
    __device__ __forceinline__ void a_ready(const pg8::Unit&) const {}
    __device__ __forceinline__ void done(const pg8::Unit&) const {}
};
struct SplitKOrder {
    int G, c;
    __device__ __forceinline__ void init(int G_, int c_) { G = G_; c = c_; }
    __device__ __forceinline__ bool next(int i, pg8::Unit& u) const { const int L = i * G + c; if (L >= 16 * KSPLIT) return false; u.pm = 128 + (L & 1); u.pn = (L >> 1) & 7; u.kb = (L >> 4) * (DFF / KSPLIT) * 2; return true; }
    __device__ __forceinline__ void a_ready(const pg8::Unit&) const {}
    __device__ __forceinline__ void done(const pg8::Unit&) const {}
};

#define EPI_HDR static constexpr bool PERM = true, AFTER_DRAIN = false;
#define EPI_ARGS const f32x4 (&acc)[2][2][4][2], const pg8::Unit& u, int wr, int wc, int fr, int fq
#define EPI_ROWS _Pragma("unroll") for (int ai = 0; ai < 2; ++ai) _Pragma("unroll") for (int m = 0; m < 4; ++m)

struct EpiIn {
    EPI_HDR
    float* out; float* cq_raw; bf16* kr_all; bf16* fq_; bf16* fk_all; bf16* fv_all; bf16* sga; bf16* sgb; const float* ropec; const float* ropes; const float* b_f;
    __device__ __forceinline__ void operator()(EPI_ARGS) const {
        const int pn = u.pn, rowb = u.pm * 256 + wr * 64 + fr, cl = wc * 32 + 8 * fq;
        if (pn < 4) {
            float* base = pn < 2 ? cq_raw : out + O_CKV; const int c0 = (pn & 1) * 256 + cl;
            EPI_ROWS { float* p = base + (size_t)(rowb + ai * 128 + m * 16) * 512 + c0;
#pragma unroll
                for (int bj = 0; bj < 2; ++bj) { *(f32x4*)(p + bj * 128) = acc[ai][bj][m][0]; *(f32x4*)(p + bj * 128 + 4) = acc[ai][bj][m][1]; } }
        } else if (pn == 4) {
            if (wc < 2) {
                const int i0 = cl >> 1;
                EPI_ROWS { const int row = rowb + ai * 128 + m * 16, pos = pos_of(row), kvr = kvrow_of(row);
                    const f32x4 c4 = *(const f32x4*)(ropec + pos * 32 + i0), s4 = *(const f32x4*)(ropes + pos * 32 + i0);
                    const f32x4 v0 = acc[ai][0][m][0], v1 = acc[ai][0][m][1];
                    f32x4 o1, o2;
                    o1[0] = v0[0] * c4[0] - v0[1] * s4[0]; o2[0] = v0[1] * c4[0] + v0[0] * s4[0];
                    o1[1] = v0[2] * c4[1] - v0[3] * s4[1]; o2[1] = v0[3] * c4[1] + v0[2] * s4[1];
                    o1[2] = v1[0] * c4[2] - v1[1] * s4[2]; o2[2] = v1[1] * c4[2] + v1[0] * s4[2];
                    o1[3] = v1[2] * c4[3] - v1[3] * s4[3]; o2[3] = v1[3] * c4[3] + v1[2] * s4[3];
                    float* po = out + O_KR + (size_t)row * 64 + i0; *(f32x4*)po = o1; *(f32x4*)(po + 32) = o2;
                    bf16* pb = kr_all + (size_t)kvr * 64 + i0; *(v2u*)pb = pack4(o1); *(v2u*)(pb + 32) = pack4(o2); }
            } else if (wc == 2 && fq == 0) {
                const f32x4 b0 = *(const f32x4*)b_f, b1 = *(const f32x4*)(b_f + 4);
                EPI_ROWS { const int row = rowb + ai * 128 + m * 16; f32x4 x0 = acc[ai][0][m][0] + b0, x1 = acc[ai][0][m][1] + b1, l0, l1;
#pragma unroll
                    for (int k = 0; k < 4; ++k) { l0[k] = fminf(x0[k], 0.f) - log1pf(expf(-fabsf(x0[k]))); l1[k] = fminf(x1[k], 0.f) - log1pf(expf(-fabsf(x1[k]))); }
                    float* po = out + O_LF + (size_t)row * 8; *(f32x4*)po = l0; *(f32x4*)(po + 4) = l1; }
            }
        } else if (pn < 9) {
            const int c0 = (pn - 5) * 256 + cl;
            EPI_ROWS { bf16* p = fq_ + (size_t)(rowb + ai * 128 + m * 16) * FW + c0;
#pragma unroll
                for (int bj = 0; bj < 2; ++bj) *(v4u*)(p + bj * 128) = pack8(acc[ai][bj][m][0] * FOX_C2, acc[ai][bj][m][1] * FOX_C2); }
        } else if (pn >= 17) {
            const int t = pn - 17, c0 = (t & 7) * 256 + cl; bf16* gb = t < 8 ? sga : sgb;
            EPI_ROWS { bf16* p = gb + (size_t)(rowb + ai * 128 + m * 16) * DM + c0;
#pragma unroll
                for (int bj = 0; bj < 2; ++bj) *(v4u*)(p + bj * 128) = pack8(sigmoid4(acc[ai][bj][m][0]), sigmoid4(acc[ai][bj][m][1])); }
        } else {
            const bool isk = pn < 13; const int c0 = (pn - (isk ? 9 : 13)) * 256 + cl; float* ob = out + (isk ? O_FK : O_FV); bf16* bb = isk ? fk_all : fv_all;
            EPI_ROWS { const int row = rowb + ai * 128 + m * 16, kvr = kvrow_of(row); float* po = ob + (size_t)row * FW + c0; bf16* pb = bb + (size_t)kvr * FW + c0;
#pragma unroll
                for (int bj = 0; bj < 2; ++bj) { *(f32x4*)(po + bj * 128) = acc[ai][bj][m][0]; *(f32x4*)(po + bj * 128 + 4) = acc[ai][bj][m][1]; *(v4u*)(pb + bj * 128) = pack8(acc[ai][bj][m][0], acc[ai][bj][m][1]); } }
        }
    }
};
struct EpiSig {
    EPI_HDR
    bf16* sga; bf16* sgb;
    __device__ __forceinline__ void operator()(EPI_ARGS) const {
        const int pn = u.pn, rowb = u.pm * 256 + wr * 64 + fr, c0 = (pn & 7) * 256 + wc * 32 + 8 * fq; bf16* gb = pn < 8 ? sga : sgb;
        EPI_ROWS { bf16* p = gb + (size_t)(rowb + ai * 128 + m * 16) * DM + c0;
#pragma unroll
            for (int bj = 0; bj < 2; ++bj) *(v4u*)(p + bj * 128) = pack8(sigmoid4(acc[ai][bj][m][0]), sigmoid4(acc[ai][bj][m][1])); }
    }
};
struct EpiQ {
    EPI_HDR
    bf16* Qm; const float* ropec; const float* ropes;
    __device__ __forceinline__ void operator()(EPI_ARGS) const {
        const int pn = u.pn, rowb = u.pm * 256 + wr * 64 + fr, cl = wc * 32 + 8 * fq;
        if (pn < 4) {
            EPI_ROWS { bf16* p = Qm + (size_t)(rowb + ai * 128 + m * 16) * NQ;
#pragma unroll
                for (int bj = 0; bj < 2; ++bj) { const int c = pn * 256 + bj * 128 + cl, h = c >> 7, d = c & 127;
                    *(v4u*)(p + h * 192 + d) = pack8(acc[ai][bj][m][0] * MLA_C2, acc[ai][bj][m][1] * MLA_C2); } }
        } else {
            EPI_ROWS { const int row = rowb + ai * 128 + m * 16, pos = pos_of(row); bf16* p = Qm + (size_t)row * NQ;
#pragma unroll
                for (int bj = 0; bj < 2; ++bj) { const int c = (pn - 4) * 256 + bj * 128 + cl, h = c >> 6, i0 = (c & 63) >> 1;
                    const f32x4 c4 = *(const f32x4*)(ropec + pos * 32 + i0) * MLA_C2, s4 = *(const f32x4*)(ropes + pos * 32 + i0) * MLA_C2;
                    const f32x4 v0 = acc[ai][bj][m][0], v1 = acc[ai][bj][m][1];
                    f32x4 o1, o2;
                    o1[0] = v0[0] * c4[0] - v0[1] * s4[0]; o2[0] = v0[1] * c4[0] + v0[0] * s4[0];
                    o1[1] = v0[2] * c4[1] - v0[3] * s4[1]; o2[1] = v0[3] * c4[1] + v0[2] * s4[1];
                    o1[2] = v1[0] * c4[2] - v1[1] * s4[2]; o2[2] = v1[1] * c4[2] + v1[0] * s4[2];
                    o1[3] = v1[2] * c4[3] - v1[3] * s4[3]; o2[3] = v1[3] * c4[3] + v1[2] * s4[3];
                    bf16* pb = p + h * 192 + 128 + i0; *(v2u*)pb = pack4(o1); *(v2u*)(pb + 32) = pack4(o2); } }
        }
    }
};
struct EpiKV {
    EPI_HDR
    bf16* Km; bf16* Vm;
    __device__ __forceinline__ void operator()(EPI_ARGS) const {
        const int rowb = u.pm * 256 + wr * 64 + fr, c0 = u.pn * 128 + wc * 32 + 8 * fq;
        EPI_ROWS { const size_t off = (size_t)(rowb + ai * 128 + m * 16) * 1024 + c0;
            *(v4u*)(Km + off) = pack8(acc[ai][0][m][0], acc[ai][0][m][1]); *(v4u*)(Vm + off) = pack8(acc[ai][1][m][0], acc[ai][1][m][1]); }
    }
};
template <bool SECOND> struct EpiGate {
    EPI_HDR
    const bf16* g; const bf16* gS; bf16* mg;
    __device__ __forceinline__ void operator()(EPI_ARGS) const {
        const int rowb = u.pm * 256 + wr * 64 + fr, c0 = u.pn * 256 + wc * 32 + 8 * fq;
        const bf16* gq = u.pm >= MP / 256 ? gS - (size_t)MP * DM : g;
#pragma unroll
        for (int ai = 0; ai < 2; ++ai) {
            v4u gv[4][2], pv[4][2];
#pragma unroll
            for (int m = 0; m < 4; ++m) { const size_t off = (size_t)(rowb + ai * 128 + m * 16) * DM + c0;
#pragma unroll
                for (int bj = 0; bj < 2; ++bj) { gv[m][bj] = *(const v4u*)(gq + off + bj * 128); if (SECOND) pv[m][bj] = *(const v4u*)(mg + off + bj * 128); } }
            asm volatile("" ::: "memory");
#pragma unroll
            for (int m = 0; m < 4; ++m) { const size_t off = (size_t)(rowb + ai * 128 + m * 16) * DM + c0;
#pragma unroll
                for (int bj = 0; bj < 2; ++bj) { f32x4 g0, g1; unpack8(gv[m][bj], g0, g1);
#if defined(DBG_NOGATE)
                    g0 = (f32x4){1.f, 1.f, 1.f, 1.f}; g1 = g0;
#endif
                    f32x4 r0 = g0 * acc[ai][bj][m][0], r1 = g1 * acc[ai][bj][m][1];
                    if (SECOND) { f32x4 p0, p1; unpack8(pv[m][bj], p0, p1); r0 += p0; r1 += p1; }
                    *(v4u*)(mg + off + bj * 128) = pack8(r0, r1); } }
        }
    }
};
template <int MODE> struct EpiRes {
    EPI_HDR
    const float* xp; const float* xs; const bf16* hin; float* hf; bf16* hb; float* rss; const float* rss_in; const bf16* ple;
    __device__ __forceinline__ void operator()(EPI_ARGS) const {
        const int rowb = u.pm * 256 + wr * 64 + fr, c0 = u.pn * 256 + wc * 32 + 8 * fq;
        constexpr int MB = 4;
#pragma unroll
        for (int ai = 0; ai < 2; ++ai)
#pragma unroll
        for (int mb = 0; mb < 4; mb += MB) {
            f32x4 sv[MB][2][2]; v4u sb[MB][2]; v4u pl[MB][2]; float rsv[MB];
#pragma unroll
            for (int mi = 0; mi < MB; ++mi) { const int m = mb + mi, row = rowb + ai * 128 + m * 16; const size_t off = (size_t)row * DM + c0;
                rsv[mi] = MODE == 2 ? rss_in[row] : 0.f;
                if (MODE == 0) { const float* src = row < MP ? xp + off : xs + (off - (size_t)MP * DM);
#pragma unroll
                    for (int bj = 0; bj < 2; ++bj) { sv[mi][bj][0] = *(const f32x4*)(src + bj * 128); sv[mi][bj][1] = *(const f32x4*)(src + bj * 128 + 4); } }
                else {
#pragma unroll
                    for (int bj = 0; bj < 2; ++bj) { sb[mi][bj] = *(const v4u*)(hin + off + bj * 128); if (MODE == 2) pl[mi][bj] = *(const v4u*)(ple + off + bj * 128); } } }
            asm volatile("" ::: "memory");
#pragma unroll
            for (int mi = 0; mi < MB; ++mi) { const int m = mb + mi, row = rowb + ai * 128 + m * 16; const size_t off = (size_t)row * DM + c0;
                float rs = 1.f; if (MODE == 2) rs = __builtin_amdgcn_rsqf(rsv[mi] * (1.f / DM) + EPS);
                float ss = 0.f;
#pragma unroll
                for (int bj = 0; bj < 2; ++bj) { f32x4 a0 = acc[ai][bj][m][0], a1 = acc[ai][bj][m][1];
                    if (MODE == 2) { f32x4 p0, p1; unpack8(pl[mi][bj], p0, p1); a0 = sigmoid4(a0 * rs) * p0; a1 = sigmoid4(a1 * rs) * p1; }
                    f32x4 s0, s1; if (MODE == 0) { s0 = sv[mi][bj][0]; s1 = sv[mi][bj][1]; } else unpack8(sb[mi][bj], s0, s1);
                    const f32x4 r0 = s0 + a0, r1 = s1 + a1;
                    if (MODE == 2) { *(f32x4*)(hf + off + bj * 128) = r0; *(f32x4*)(hf + off + bj * 128 + 4) = r1; }
                    else *(v4u*)(hb + off + bj * 128) = pack8(r0, r1);
                    ss += (r0[0] * r0[0] + r0[1] * r0[1]) + (r0[2] * r0[2] + r0[3] * r0[3]) + (r1[0] * r1[0] + r1[1] * r1[1]) + (r1[2] * r1[2] + r1[3] * r1[3]); }
                ss += __shfl_xor(ss, 16); ss += __shfl_xor(ss, 32);
                if (fq == 0) unsafeAtomicAdd(rss + row, ss); }
        }
    }
};
struct EpiUp {
    EPI_HDR
    bf16* U; float* out; const float* rss1; int row0;
    __device__ __forceinline__ void operator()(EPI_ARGS) const {
        const int rowb = u.pm * 256 + wr * 64 + fr, c0 = u.pn * 256 + wc * 32 + 8 * fq;
        EPI_ROWS { const int row = rowb + ai * 128 + m * 16; const float rs = __builtin_amdgcn_rsqf(rss1[row] * (1.f / DM) + EPS);
            bf16* p = U + (size_t)(row - row0) * DFF2 + c0;
            int cs = -1;
            if (row < MP) { const int t = row & (TP - 1); if (t >= TP - 2) cs = (row >> 12) * 2 + (t - (TP - 2)); }
            else { const int s = row - MP, t = s & 31; if (t >= TS - 2) cs = NBP * 2 + (s >> 5) * 2 + (t - (TS - 2)); }
#pragma unroll
            for (int bj = 0; bj < 2; ++bj) { const f32x4 r0 = acc[ai][bj][m][0] * rs, r1 = acc[ai][bj][m][1] * rs;
                *(v4u*)(p + bj * 128) = pack8(r0, r1);
                if (cs >= 0) { float* po = out + O_CVP + (size_t)cs * DFF2 + bj * DFF + u.pn * 128 + wc * 32 + 8 * fq; *(f32x4*)po = r0; *(f32x4*)(po + 4) = r1; } } }
    }
};
struct EpiUpAct {
    EPI_HDR
    bf16* act; float* out; const float* rss1; const float* wconv; const float* bconv; float* Uh; LAS unsigned* halo; int row0;
    __device__ __forceinline__ void operator()(const f32x4 (&acc)[2][2][4][2], const pg8::Unit& u, int wr, int wc, int fr_in, int fq_in) const {
        (void)fr_in; (void)fq_in;
        int ln = lane_id_nv(); asm volatile("" : "+v"(ln));
        const int fr = ln & 15, fq = ln >> 4;
        const int pn = u.pn, pm = u.pm, rowb = pm * 256 + wr * 64 + fr, cl = wc * 32 + 8 * fq;
        const bool bstart = (pm & 15) == 0;
        unsigned P[2][2][4][2][2];
#pragma unroll
        for (int ai = 0; ai < 2; ++ai)
#pragma unroll
            for (int m = 0; m < 4; ++m) { const float rs = __builtin_amdgcn_rsqf(rss1[rowb + ai * 128 + m * 16] * (1.f / DM) + EPS);
#pragma unroll
                for (int bj = 0; bj < 2; ++bj) { const f32x4 s0 = acc[ai][bj][m][0] * rs, s1 = acc[ai][bj][m][1] * rs;
                    if (ai == 0 && m == 0) { if (wr == 0 && fr < 2) { float* p = Uh + ((size_t)pm * 4 + fr) * DFF2 + pn * 256 + bj * 128 + cl; *(f32x4*)p = s0; *(f32x4*)(p + 4) = s1; } }
                    if (ai == 1 && m == 3) { if (wr == 1 && fr >= 14) { float* p = Uh + ((size_t)pm * 4 + 2 + (fr - 14)) * DFF2 + pn * 256 + bj * 128 + cl; *(f32x4*)p = s0; *(f32x4*)(p + 4) = s1;
                            if ((pm & 15) == 15) { float* q = out + O_CVP + (size_t)((pm >> 4) * 2 + (fr - 14)) * DFF2 + bj * DFF + pn * 128 + cl; *(f32x4*)q = s0; *(f32x4*)(q + 4) = s1; } } }
                    P[ai][bj][m][0][0] = pk2(s0[0], s0[1]); P[ai][bj][m][0][1] = pk2(s0[2], s0[3]); P[ai][bj][m][1][0] = pk2(s1[0], s1[1]); P[ai][bj][m][1][1] = pk2(s1[2], s1[3]); } }
        if (fr >= 14) {
#pragma unroll
            for (int ai = 0; ai < 2; ++ai)
#pragma unroll
                for (int bj = 0; bj < 2; ++bj) { LAS unsigned* h = halo + ((((ai * 2 + wr) * 2 + (fr - 14)) * 2 + bj) * 64) + (cl >> 1);
                    *(LAS v4u*)h = (v4u){P[ai][bj][3][0][0], P[ai][bj][3][0][1], P[ai][bj][3][1][0], P[ai][bj][3][1][1]}; }
        }
        asm volatile("s_waitcnt lgkmcnt(0)" ::: "memory"); __builtin_amdgcn_s_barrier(); asm volatile("" ::: "memory");
        const bool l0 = fr == 0, l1 = fr == 1, l15 = fr == 15, l14 = fr >= 14;
#define DPPU(OLD, SRC, CTRL) ((unsigned)__builtin_amdgcn_update_dpp((int)(OLD), (int)(SRC), (CTRL), 0xf, 0xf, false))
#define LO16(W) __builtin_bit_cast(float, (W) << 16)
#define HI16(W) __builtin_bit_cast(float, (W) & 0xffff0000u)
#pragma unroll
        for (int ai = 0; ai < 2; ++ai) {
            const int pb = ai * 2 + wr - 1;
#pragma unroll
            for (int n = 0; n < 2; ++n) {
                f32x4 cvv[4];
#pragma unroll
                for (int bj = 0; bj < 2; ++bj) {
                    const int col = bj * DFF + pn * 128 + cl + 4 * n;
                    const f32x4 bb = *(const f32x4*)(bconv + col), w0 = *(const f32x4*)(wconv + col), w1 = *(const f32x4*)(wconv + (size_t)DFF2 + col), w2 = *(const f32x4*)(wconv + (size_t)2 * DFF2 + col);
                    unsigned c1[2], c2[2];
                    if (pb >= 0) { const LAS unsigned* h = halo + ((pb * 2 * 2 + bj) * 64) + (cl >> 1) + 2 * n; const v2u h2 = *(const LAS v2u*)h, h1 = *(const LAS v2u*)(h + 128);
#pragma unroll
                        for (int q = 0; q < 2; ++q) { c1[q] = l0 ? h1[q] : 0u; c2[q] = l0 ? h2[q] : (l1 ? h1[q] : 0u); } }
                    else { c1[0] = c1[1] = c2[0] = c2[1] = 0u; }
#pragma unroll
                    for (int m = 0; m < 4; ++m) { f32x4 cv;
#pragma unroll
                        for (int q = 0; q < 2; ++q) { const unsigned x = P[ai][bj][m][n][q]; const unsigned p1 = DPPU(c1[q], x, 0x111), p2 = DPPU(c2[q], x, 0x112);
                            cv[2 * q] = bb[2 * q] + w0[2 * q] * LO16(p2) + w1[2 * q] * LO16(p1) + w2[2 * q] * LO16(x);
                            cv[2 * q + 1] = bb[2 * q + 1] + w0[2 * q + 1] * HI16(p2) + w1[2 * q + 1] * HI16(p1) + w2[2 * q + 1] * HI16(x);
                            const unsigned e15 = l15 ? x : 0u, e14 = l14 ? x : 0u; c1[q] = DPPU(0u, e15, 0x121); c2[q] = DPPU(0u, e14, 0x122); }
                        if (bj == 0) cvv[m] = cv;
                        else { f32x4 o;
#pragma unroll
                            for (int k = 0; k < 4; ++k) { const float xg = cv[k], z = xg + 0.044715f * xg * xg * xg;
                                o[k] = cvv[m][k] * xg * __builtin_amdgcn_rcpf(1.f + __builtin_amdgcn_exp2f(-2.f * 0.7978845608028654f * LOG2E * z)); }
                            const int row = rowb + ai * 128 + m * 16;
                            if (!(ai == 0 && m == 0 && wr == 0 && fr < 2 && !bstart)) *(v2u*)(act + (size_t)(row - row0) * DFF + pn * 128 + cl + 4 * n) = pack4(o); }
                    }
                    asm volatile("" ::: "memory"); __builtin_amdgcn_sched_barrier(0);
                }
            }
        }
#undef DPPU
#undef LO16
#undef HI16
        asm volatile("s_waitcnt lgkmcnt(0)" ::: "memory"); __builtin_amdgcn_s_barrier(); asm volatile("" ::: "memory");
    }
};
struct EpiSlab {
    EPI_HDR
    float* slab;
    __device__ __forceinline__ void operator()(EPI_ARGS) const {
        const int rowb = u.pm * 256 + wr * 64 + fr - MP, c0 = u.pn * 256 + wc * 32 + 8 * fq, ks = u.kb / ((DFF / KSPLIT) * 2);
        EPI_ROWS { float* p = slab + ((size_t)ks * MS + rowb + ai * 128 + m * 16) * DM + c0;
#pragma unroll
            for (int bj = 0; bj < 2; ++bj) { *(f32x4*)(p + bj * 128) = acc[ai][bj][m][0]; *(f32x4*)(p + bj * 128 + 4) = acc[ai][bj][m][1]; } }
    }
};
struct EpiPle {
    EPI_HDR
    bf16* O;
    __device__ __forceinline__ void operator()(EPI_ARGS) const {
        const int rowb = u.pm * 256 + wr * 64 + fr, c0 = u.pn * 256 + wc * 32 + 8 * fq;
        EPI_ROWS { bf16* p = O + (size_t)(rowb + ai * 128 + m * 16) * DM + c0;
#pragma unroll
            for (int bj = 0; bj < 2; ++bj) *(v4u*)(p + bj * 128) = pack8(acc[ai][bj][m][0], acc[ai][bj][m][1]); }
    }
};

namespace att {
#ifndef ATT_THR
#define ATT_THR 0.0f
#endif
constexpr int SHM_V = 16384, SHM_K = 16384, SHM_KR = 8192;
constexpr int L_V = 0, L_K = 32768, L_KR = 65536, L_CK = 81920, L_WS = 82432, L_MM = 84480, L_END = 84544;
static_assert(L_END <= RING_BYTES, "attention LDS");
#define KSWZ(row, colB) ((row) * 256 + ((colB) ^ (((row) & 7) << 4)))
#define KRSWZ(row, colB) ((row) * 128 + ((colB) ^ ((((row) >> 1) & 7) << 4)))
#define SBAR() __builtin_amdgcn_sched_barrier(0)
__device__ __forceinline__ int crow(int r, int hi) { return (r & 3) + 8 * (r >> 2) + 4 * hi; }
__device__ __forceinline__ unsigned cvtpk(float lo, float hi) { return pk2(lo, hi); }
__device__ __forceinline__ int v_st(int k, int c) { const int kk = (k & ~0xC) | ((k & 4) << 1) | ((k & 8) >> 1); return ((kk >> 3) * 4 + (c >> 5)) * 512 + ((kk & 7) * 32 + (c & 31)) * 2; }
__device__ __forceinline__ int v_rd_base(int lane) { return ((lane & 3) << 3) | (((lane >> 2) & 3) << 6) | (((lane >> 4) & 1) << 5) | (((lane >> 5) & 1) << 8); }
constexpr int v_rd_off(int d0, int ks, int half) { return d0 * 512 + ks * 4096 + half * 2048; }
template <int OFF> __device__ __forceinline__ s16x4 tr_read(int vb) {
    s16x4 r; asm volatile("ds_read_b64_tr_b16 %0, %1 offset:%2" : "=&v"(r) : "v"(vb), "i"(OFF) : "memory"); return r;
}
template <int D0> __device__ __forceinline__ void pv_one(f32x16& od, int vb, bf16x8 pa0, bf16x8 pa1, bf16x8 pa2, bf16x8 pa3) {
    const s16x4 l0 = tr_read<v_rd_off(D0, 0, 0)>(vb), h0 = tr_read<v_rd_off(D0, 0, 1)>(vb), l1 = tr_read<v_rd_off(D0, 1, 0)>(vb), h1 = tr_read<v_rd_off(D0, 1, 1)>(vb);
    const s16x4 l2 = tr_read<v_rd_off(D0, 2, 0)>(vb), h2 = tr_read<v_rd_off(D0, 2, 1)>(vb), l3 = tr_read<v_rd_off(D0, 3, 0)>(vb), h3 = tr_read<v_rd_off(D0, 3, 1)>(vb);
    asm volatile("s_waitcnt lgkmcnt(0)" ::: "memory"); SBAR();
#define PK(L, H) (bf16x8){L[0], L[1], L[2], L[3], H[0], H[1], H[2], H[3]}
    od = __builtin_amdgcn_mfma_f32_32x32x16_bf16(pa0, PK(l0, h0), od, 0, 0, 0);
    od = __builtin_amdgcn_mfma_f32_32x32x16_bf16(pa1, PK(l1, h1), od, 0, 0, 0);
    od = __builtin_amdgcn_mfma_f32_32x32x16_bf16(pa2, PK(l2, h2), od, 0, 0, 0);
    od = __builtin_amdgcn_mfma_f32_32x32x16_bf16(pa3, PK(l3, h3), od, 0, 0, 0);
#undef PK
}
#define PK(L, H) (bf16x8){L[0], L[1], L[2], L[3], H[0], H[1], H[2], H[3]}
#define PV_READ(KS, L, H) do { L[0] = tr_read<v_rd_off(0, KS, 0)>(vb); H[0] = tr_read<v_rd_off(0, KS, 1)>(vb); L[1] = tr_read<v_rd_off(1, KS, 0)>(vb); H[1] = tr_read<v_rd_off(1, KS, 1)>(vb); \
        L[2] = tr_read<v_rd_off(2, KS, 0)>(vb); H[2] = tr_read<v_rd_off(2, KS, 1)>(vb); L[3] = tr_read<v_rd_off(3, KS, 0)>(vb); H[3] = tr_read<v_rd_off(3, KS, 1)>(vb); } while (0)
#define PV_MMA(PA, L, H) do { o[0] = __builtin_amdgcn_mfma_f32_32x32x16_bf16(PA, PK(L[0], H[0]), o[0], 0, 0, 0); o[1] = __builtin_amdgcn_mfma_f32_32x32x16_bf16(PA, PK(L[1], H[1]), o[1], 0, 0, 0); \
        o[2] = __builtin_amdgcn_mfma_f32_32x32x16_bf16(PA, PK(L[2], H[2]), o[2], 0, 0, 0); o[3] = __builtin_amdgcn_mfma_f32_32x32x16_bf16(PA, PK(L[3], H[3]), o[3], 0, 0, 0); } while (0)
__device__ __forceinline__ void pv_all(f32x16 (&o)[4], int vb, bf16x8 pa0, bf16x8 pa1, bf16x8 pa2, bf16x8 pa3) {
    s16x4 la[4], ha[4], lb[4], hb_[4];
    PV_READ(0, la, ha); PV_READ(1, lb, hb_);
    asm volatile("s_waitcnt lgkmcnt(8)" ::: "memory"); SBAR(); PV_MMA(pa0, la, ha);
    PV_READ(2, la, ha);
    asm volatile("s_waitcnt lgkmcnt(8)" ::: "memory"); SBAR(); PV_MMA(pa1, lb, hb_);
    PV_READ(3, lb, hb_);
    asm volatile("s_waitcnt lgkmcnt(8)" ::: "memory"); SBAR(); PV_MMA(pa2, la, ha);
    asm volatile("s_waitcnt lgkmcnt(0)" ::: "memory"); SBAR(); PV_MMA(pa3, lb, hb_);
}
#undef PV_READ
#undef PV_MMA
#undef PK
struct Tensors { const bf16* Q; const bf16* K; const bf16* V; const bf16* KR; const float* ncumP; const float* ncumS; bf16* O; const unsigned* qkmax; const float* Kc; const float* Vc; const float* Kn; const float* Vn; };

template <bool FOX, bool F32 = false>
__device__ __forceinline__ void attn_unit(const Tensors& T, bool sample, int b, int h, int qb, LAS unsigned char* lds, const int wave_id) {
    constexpr int NQ0 = FOX ? 8 : 12, LDQ = FOX ? FW : NQ, QH = FOX ? HD : 192;
    int tid_ = wave_id * 64 + lane_id_nv(); asm volatile("" : "+v"(tid_));
    const int tid = tid_, wid = __builtin_amdgcn_readfirstlane(tid >> 6), lane = tid & 63, r32 = lane & 31, hi = lane >> 5;
    int kvrow0, nt, qidx0, qrow_w; bool active;
    if (!sample) { kvrow0 = b * TP; nt = 4 * qb + 4; qidx0 = qb * 256 + 32 * wid; qrow_w = b * TP + qidx0; active = true; }
    else { kvrow0 = MP + b * SKV; nt = 33; qidx0 = PAST; qrow_w = MP + b * TS; active = (wid == 0); }
    int jfull, jmax, limit;
    if (FOX) { limit = qidx0 + r32; jfull = (qidx0 + 1) >> 6; jmax = (qidx0 + 31) >> 6; }
    else if (!sample) { jmax = qidx0 >> 6; jfull = jmax + 1; limit = 0x7fffffff; }
    else { jmax = 32; jfull = 32; limit = SKV - 1; }
    if (!active) jmax = -1;
    LAS float* ws = (LAS float*)(lds + L_WS) + wid * 64; LAS float* li_l = ws; LAS float* al_l = ws + 32;
    float m_reg = -1e30f, l_reg = 0.f; f32x16 o[4];
#pragma unroll
    for (int d = 0; d < 4; ++d)
#pragma unroll
        for (int r = 0; r < 16; ++r) o[d][r] = 0.f;
    bf16x8 qr[NQ0];
    { const bf16* Qw = T.Q + (size_t)(qrow_w + r32) * LDQ + h * QH + hi * 8;
#pragma unroll
      for (int d0 = 0; d0 < NQ0; ++d0) qr[d0] = *(const bf16x8*)(Qw + d0 * 16); }
    const bf16* Kh = T.K + (size_t)kvrow0 * 1024 + h * HD; const bf16* Vh = T.V + (size_t)kvrow0 * 1024 + h * HD;
    const bf16* KRh = T.KR + (size_t)kvrow0 * 64; const float* CKh = sample ? T.ncumS + (size_t)(b * NH + h) * SCUM : T.ncumP + (size_t)(b * NH + h) * TP;
    const int sr = tid >> 4, sc = (tid & 15) * 8, vst0 = v_st(sr, sc), vst1 = v_st(32 + sr, sc), krr = tid >> 3, krc = (tid & 7) * 8;
    const int vb0 = (int)(uintptr_t)(lds + L_V) + v_rd_base(lane);
    unsigned kq[4], rq[4];
#pragma unroll
    for (int q = 0; q < 4; ++q) { kq[q] = (unsigned)KSWZ(r32, (q * 16 + hi * 8) * 2); rq[q] = (unsigned)KRSWZ(r32, (q * 16 + hi * 8) * 2); }
    bf16x8 sv0, sv1, sk0, sk1, skr; f32x4 sck; f32x4 fv0[2], fv1[2], fk0[2], fk1[2];
    const float* Kcf = nullptr; const float* Vcf = nullptr; const float* Knf = nullptr; const float* Vnf = nullptr;
    if (F32) { Kcf = T.Kc + (size_t)b * PAST * 1024 + h * HD + sc; Vcf = T.Vc + (size_t)b * PAST * 1024 + h * HD + sc; Knf = T.Kn + (size_t)(MP + b * TS) * 1024 + h * HD + sc; Vnf = T.Vn + (size_t)(MP + b * TS) * 1024 + h * HD + sc; }
#define LD8F(DST, P) do { DST[0] = *(const f32x4*)(P); DST[1] = *(const f32x4*)((P) + 4); } while (0)
#define SLOAD(k0) do { if (F32) { const f32x4 z4 = {0.f, 0.f, 0.f, 0.f}; \
            if ((k0) < PAST) { LD8F(fv0, Vcf + (size_t)((k0) + sr) * 1024); LD8F(fv1, Vcf + (size_t)((k0) + 32 + sr) * 1024); LD8F(fk0, Kcf + (size_t)((k0) + sr) * 1024); LD8F(fk1, Kcf + (size_t)((k0) + 32 + sr) * 1024); } \
            else { LD8F(fv0, Vnf + (size_t)sr * 1024); LD8F(fk0, Knf + (size_t)sr * 1024); fv1[0] = fv1[1] = fk1[0] = fk1[1] = z4; }     \
        } else { sv0 = *(const bf16x8*)(Vh + (size_t)((k0) + sr) * 1024 + sc); sv1 = *(const bf16x8*)(Vh + (size_t)((k0) + 32 + sr) * 1024 + sc); \
        sk0 = *(const bf16x8*)(Kh + (size_t)((k0) + sr) * 1024 + sc); sk1 = *(const bf16x8*)(Kh + (size_t)((k0) + 32 + sr) * 1024 + sc); } \
        if (!FOX) skr = *(const bf16x8*)(KRh + (size_t)((k0) + krr) * 64 + krc); \
        if (FOX) { if (tid < 16) sck = *(const f32x4*)(CKh + (k0) + 4 * tid); } } while (0)
#define SWRITE(bf) do { if (F32) { sv0 = __builtin_bit_cast(bf16x8, pack8(fv0[0], fv0[1])); sv1 = __builtin_bit_cast(bf16x8, pack8(fv1[0], fv1[1])); sk0 = __builtin_bit_cast(bf16x8, pack8(fk0[0], fk0[1])); sk1 = __builtin_bit_cast(bf16x8, pack8(fk1[0], fk1[1])); } \
        *(LAS bf16x8*)(lds + L_V + (bf) * SHM_V + vst0) = sv0; *(LAS bf16x8*)(lds + L_V + (bf) * SHM_V + vst1) = sv1; \
        *(LAS bf16x8*)(lds + L_K + (bf) * SHM_K + KSWZ(sr, sc * 2)) = sk0; *(LAS bf16x8*)(lds + L_K + (bf) * SHM_K + KSWZ(32 + sr, sc * 2)) = sk1; \
        if (!FOX) *(LAS bf16x8*)(lds + L_KR + (bf) * SHM_KR + KRSWZ(krr, krc * 2)) = skr; \
        if (FOX) { if (tid < 16) *(LAS f32x4*)(lds + L_CK + (bf) * 256 + tid * 16) = sck; } } while (0)
    float sbound = 0.f;
    if (FOX) sbound = 1.01f * sqrtf(__builtin_bit_cast(float, __builtin_amdgcn_readfirstlane(T.qkmax[0])) * __builtin_bit_cast(float, __builtin_amdgcn_readfirstlane(T.qkmax[64])));
    LAS float* mm = (LAS float*)(lds + L_MM);
    SLOAD((nt - 1) * 64); SWRITE(0); __syncthreads();
    for (int jj = 0; jj < nt; ++jj) {
        const int j = nt - 1 - jj, bf = jj & 1;
        if (jj + 1 < nt) SLOAD((j - 1) * 64);
        if (j <= jmax) {
            f32x16 p0, p1;
            if (FOX) { const LAS f32x4* ckp = (const LAS f32x4*)(lds + L_CK + bf * 256);
#pragma unroll
                for (int g = 0; g < 4; ++g) { const f32x4 a = ckp[2 * g + hi], c = ckp[8 + 2 * g + hi];
                    p0[4 * g] = a[0]; p0[4 * g + 1] = a[1]; p0[4 * g + 2] = a[2]; p0[4 * g + 3] = a[3]; p1[4 * g] = c[0]; p1[4 * g + 1] = c[1]; p1[4 * g + 2] = c[2]; p1[4 * g + 3] = c[3]; } }
            else {
#pragma unroll
                for (int r = 0; r < 16; ++r) { p0[r] = 0.f; p1[r] = 0.f; } }
            {
                const unsigned kbase = (unsigned)(uintptr_t)(lds + L_K) + (unsigned)bf * SHM_K, rbase = (unsigned)(uintptr_t)(lds + L_KR) + (unsigned)bf * SHM_KR;
#define KREAD(DST, ADDR, OFF) asm volatile("ds_read_b128 %0, %1 offset:%2" : "=&v"(DST) : "v"(ADDR), "i"(OFF) : "memory")
#define KSTEP_READ(D0) do { if ((D0) < 8) { KREAD(ka[(D0) & 3], kbase + kq[(D0) & 3], ((D0) >> 2) * 128); KREAD(kb_[(D0) & 3], kbase + kq[(D0) & 3], ((D0) >> 2) * 128 + 8192); } \
                            else { KREAD(ka[(D0) & 3], rbase + rq[(D0) & 3], 0); KREAD(kb_[(D0) & 3], rbase + rq[(D0) & 3], 4096); } } while (0)
                bf16x8 ka[4], kb_[4];
                KSTEP_READ(0); KSTEP_READ(1); KSTEP_READ(2); KSTEP_READ(3);
                __builtin_amdgcn_s_setprio(1);
#pragma unroll
                for (int d0 = 0; d0 < NQ0; ++d0) {
                    if (d0 + 3 < NQ0) asm volatile("s_waitcnt lgkmcnt(6)" ::: "memory"); else if (d0 + 2 < NQ0) asm volatile("s_waitcnt lgkmcnt(4)" ::: "memory");
                    else if (d0 + 1 < NQ0) asm volatile("s_waitcnt lgkmcnt(2)" ::: "memory"); else asm volatile("s_waitcnt lgkmcnt(0)" ::: "memory");
                    SBAR();
                    const bf16x8 a = ka[d0 & 3], b = kb_[d0 & 3];
                    p0 = __builtin_amdgcn_mfma_f32_32x32x16_bf16(a, qr[d0], p0, 0, 0, 0); p1 = __builtin_amdgcn_mfma_f32_32x32x16_bf16(b, qr[d0], p1, 0, 0, 0);
                    SBAR();
                    if (d0 + 4 < NQ0) { if (d0 + 4 == 4) { KSTEP_READ(4); } else if (d0 + 4 == 5) { KSTEP_READ(5); } else if (d0 + 4 == 6) { KSTEP_READ(6); } else if (d0 + 4 == 7) { KSTEP_READ(7); }
                        else if (d0 + 4 == 8) { KSTEP_READ(8); } else if (d0 + 4 == 9) { KSTEP_READ(9); } else if (d0 + 4 == 10) { KSTEP_READ(10); } else { KSTEP_READ(11); } }
                }
                __builtin_amdgcn_s_setprio(0);
#undef KSTEP_READ
#undef KREAD
            }
            if (j >= jfull) { const int kb = 64 * j + 4 * hi;
#pragma unroll
                for (int r = 0; r < 16; ++r) { const int kv = kb + (r & 3) + 8 * (r >> 2); if (kv > limit) p0[r] = -1e30f; if (kv + 32 > limit) p1[r] = -1e30f; } }
            float pmax = p0[0];
#pragma unroll
            for (int r = 1; r < 16; ++r) pmax = fmaxf(pmax, p0[r]);
#pragma unroll
            for (int r = 0; r < 16; ++r) pmax = fmaxf(pmax, p1[r]);
            { auto rr = __builtin_amdgcn_permlane32_swap(__float_as_uint(pmax), __float_as_uint(pmax), false, false); pmax = fmaxf(__uint_as_float(rr[0]), __uint_as_float(rr[1])); }
            float alpha = 1.f;
            if (!__all(pmax - m_reg <= ATT_THR)) {
                const float mn = fmaxf(m_reg, pmax); alpha = __builtin_amdgcn_exp2f(m_reg - mn); m_reg = mn;
                if (hi == 0) al_l[r32] = alpha; LDS_WAIT();
#pragma unroll
                for (int r = 0; r < 16; ++r) { const float a = al_l[crow(r, hi)];
#pragma unroll
                    for (int d = 0; d < 4; ++d) o[d][r] *= a; }
            }
#pragma unroll
            for (int r = 0; r < 16; ++r) { p0[r] = __builtin_amdgcn_exp2f(p0[r] - m_reg); p1[r] = __builtin_amdgcn_exp2f(p1[r] - m_reg); }
            float ps = 0.f;
#pragma unroll
            for (int r = 0; r < 16; ++r) ps += p0[r] + p1[r];
            { auto rr = __builtin_amdgcn_permlane32_swap(__float_as_uint(ps), __float_as_uint(ps), false, false); ps = __uint_as_float(rr[0]) + __uint_as_float(rr[1]); }
            l_reg = l_reg * alpha + ps;
            bf16x8 pa0, pa1, pa2, pa3;
#define PK4(P, BASE, OUT) do { unsigned a0 = cvtpk(P[BASE + 0], P[BASE + 1]), a1 = cvtpk(P[BASE + 2], P[BASE + 3]);   \
    unsigned b0 = cvtpk(P[BASE + 4], P[BASE + 5]), b1 = cvtpk(P[BASE + 6], P[BASE + 7]);                              \
    auto r0 = __builtin_amdgcn_permlane32_swap(a0, b0, false, false); auto r1 = __builtin_amdgcn_permlane32_swap(a1, b1, false, false); \
    v4u w = {r0[0], r1[0], r0[1], r1[1]}; OUT = __builtin_bit_cast(bf16x8, w); } while (0)
            PK4(p0, 0, pa0); PK4(p0, 8, pa1); PK4(p1, 0, pa2); PK4(p1, 8, pa3);
#undef PK4
            const int vb = vb0 + bf * SHM_V;
            __builtin_amdgcn_s_setprio(1); pv_all(o, vb, pa0, pa1, pa2, pa3); __builtin_amdgcn_s_setprio(0);
        }
        if (jj + 1 < nt) SWRITE(bf ^ 1);
        float nextb = 0.f;
        if (FOX) { if (j > 0) nextb = CKh[(j - 1) * 64 + 63];
            float mw = active ? m_reg : 1e30f;
#pragma unroll
            for (int o_ = 1; o_ < 64; o_ <<= 1) mw = fminf(mw, __shfl_xor(mw, o_));
            if (lane == 0) mm[(jj & 1) * 8 + wid] = mw; }
        __syncthreads();
        if (FOX) { const f32x4 m0 = *(const LAS f32x4*)(mm + (jj & 1) * 8), m1 = *(const LAS f32x4*)(mm + (jj & 1) * 8 + 4);
            const float mall = fminf(fminf(fminf(m0[0], m0[1]), fminf(m0[2], m0[3])), fminf(fminf(m1[0], m1[1]), fminf(m1[2], m1[3])));
            if (j > 0 && sbound + nextb - mall < -140.f) break; }
    }
    if (active) {
        if (hi == 0) li_l[r32] = l_reg; LDS_WAIT();
        bf16* Ow = T.O + (size_t)qrow_w * 1024 + h * HD + r32;
#pragma unroll
        for (int r = 0; r < 16; ++r) { const int orow = crow(r, hi); const float rl = __builtin_amdgcn_rcpf(li_l[orow]);
#pragma unroll
            for (int d0 = 0; d0 < 4; ++d0) Ow[(size_t)orow * 1024 + d0 * 32] = (bf16)f2bf(o[d0][r] * rl); }
    }
#undef SLOAD
#undef SWRITE
#undef LD8F
}
constexpr int NUNITS = 16 * 64 + 128;
template <bool FOX>
__device__ __forceinline__ void attn_phase(const Tensors& T, gu32* qhead, LAS unsigned char* lds, volatile LAS unsigned* misc, const int wave_id) {
    for (;;) {
        if (wave_id == 0 && (unsigned)lane_id_nv() == 0) misc[0] = __hip_atomic_fetch_add(qhead, 1u, RLX_AGENT);
        __syncthreads();
        const int idx = (int)misc[0];
        if (idx >= NUNITS) break;
        bool sample = false; int b, h, qb = 0;
        if (idx >= 512 && idx < 640) { sample = true; const int s = idx - 512; b = s >> 3; h = s & 7; }
        else { const int i2 = idx < 512 ? idx : idx - 128; qb = 15 - (i2 >> 6); const int bh = i2 & 63; b = bh >> 3; h = bh & 7; }
        if (FOX && sample) attn_unit<FOX, FOX>(T, sample, b, h, qb, lds, wave_id); else attn_unit<FOX, false>(T, sample, b, h, qb, lds, wave_id);
    }
    __syncthreads();
}
#undef KSWZ
#undef KRSWZ
#undef SBAR
}

struct Args { const float* in[29]; float* out; unsigned char* ws; int ph_lo, ph_hi; };
static_assert(sizeof(Args) == 29 * 8 + 8 + 8 + 8, "Args has no padding");
enum { I_XP = 0, I_XS, I_CCKV, I_CKR, I_CFK, I_CFV, I_CLF, I_CONV, I_PP, I_PS, I_GMIX, I_WIN, I_BF, I_GQ, I_WUQ, I_GKV, I_WUKV, I_WOA, I_WOB, I_WO, I_GFFN, I_WUP, I_WCONV, I_BCONV,
       I_WDN, I_GPLE, I_WPG, I_WPLE, I_GFIN };

#define CAS __attribute__((address_space(4)))
__device__ __forceinline__ const float* arg_in(int k) { const CAS char* ka = (const CAS char*)__builtin_amdgcn_kernarg_segment_ptr(); return *(const float* const volatile CAS*)(ka + 8 * k); }
template <int MAP> __device__ __forceinline__ int dst_row(int j) {
    if (MAP == 0) return j;
    if (MAP == 1) {
        if (j < 1024) return j;
        if (j < 1088) { const int e = j - 1024; return e < 32 ? 1024 + 2 * e : 1024 + 2 * (e - 32) + 1; }
        if (j < 4160) return j + 192;
        if (j < 4168) return 1088 + (j - 4160);
        return j + 184;
    }
    if (MAP == 3) { const bool gate = j >= DFF; const int jj = gate ? j - DFF : j; return (jj >> 7) * 256 + (gate ? 128 : 0) + (jj & 127); }
    { const int h = j / 192, d = j - h * 192;
      if (d < 128) return h * 128 + d; const int e = d - 128; return 1024 + h * 64 + (e < 32 ? 2 * e : 2 * (e - 32) + 1); }
}
template <int MAP> __device__ __forceinline__ void tr_item(const float* W, int K, int N, const float* gain, bf16* WT, LAS float* scr, int item, int lane) {
    const int nblk = (N + 31) / 32, kb = item / nblk, nb = item - kb * nblk, k0 = 64 * kb, n0 = 32 * nb;
    const int col = n0 + (lane & 31); const bool okc = col < N;
    float vv[32];
#pragma unroll
    for (int i = 0; i < 32; ++i) { const int kk = 2 * i + (lane >> 5); vv[i] = okc ? W[(size_t)(k0 + kk) * N + col] : 0.f; }
#pragma unroll
    for (int i = 0; i < 32; ++i) { const int kk = 2 * i + (lane >> 5); float v = vv[i]; if (gain) v *= gain[k0 + kk]; scr[kk * 33 + (lane & 31)] = v; }
    LDS_WAIT(); asm volatile("" ::: "memory");
    const int c = lane & 7;
#pragma unroll
    for (int j = 0; j < 4; ++j) { const int n = (lane >> 3) + 8 * j; const LAS float* s = scr + (8 * c) * 33 + n;
        v4u o; o.x = pk2(s[0 * 33], s[1 * 33]); o.y = pk2(s[2 * 33], s[3 * 33]); o.z = pk2(s[4 * 33], s[5 * 33]); o.w = pk2(s[6 * 33], s[7 * 33]);
        if (n0 + n < N) *(v4u*)(WT + (size_t)dst_row<MAP>(n0 + n) * K + k0 + 8 * c) = o; }
    LDS_WAIT(); asm volatile("" ::: "memory");
}
__device__ __forceinline__ void cvt8(const float* s, bf16* d) { const f32x4 a = *(const f32x4*)s, b = *(const f32x4*)(s + 4); *(v4u*)d = pack8(a, b); }

__global__ void __launch_bounds__(NWAVES * 64, 2) mega_fwd(Args args) {
    extern __shared__ __attribute__((aligned(16))) unsigned char lds_raw[];
    LAS unsigned char* lds = (LAS unsigned char*)lds_raw;
    volatile LAS unsigned* MISC = (volatile LAS unsigned*)(lds + MISC_OFF);
#define lane (lane_id_nv())
#define tid (wave * 64 + lane)
    const int wave = __builtin_amdgcn_readfirstlane(threadIdx.x >> 6);
    const int G = gridDim.x; const int bx = blockIdx.x; const int vcu = (G % 8 == 0) ? (bx % 8) * (G / 8) + bx / 8 : bx;
    unsigned char* ws = args.ws; float* out = args.out;
    gu32* ctl = (gu32*)(ws + WS_CTL);
    for (int u = tid; u < (LDS_BYTES - LDSCTL_OFF) / 4; u += NWAVES * 64) ((LAS unsigned*)(lds + LDSCTL_OFF))[u] = 0u;
    __syncthreads();
    XcdBarrier bar = xcd_barrier_post((unsigned*)(ws + WS_CTL) + CW_BAR, MISC + 8);
    const int lo = args.ph_lo, hi = args.ph_hi;
#ifndef ALIGN_P1
#define ALIGN_P1 true
#endif
#ifndef ALIGN_HEAVY
#define ALIGN_HEAVY true
#endif
#ifndef PHMASK
#define PHMASK 0xFFFFFFFFu
#endif
#define IN(k) (((PHMASK >> ((k) < 9 ? (k) : ((k) < 18 ? 9 + ((k) - 9) % 3 : (k) - 6))) & 1u) && lo <= (k) && (k) < hi)
#define SEAM(k) do { if (IN(k) && IN((k) + 1)) xcd_barrier(bar); } while (0)
#define ropec ((float*)(ws + WS_ROPE))
#define ropes (((float*)(ws + WS_ROPE)) + TP * 32)
#define ncumP ((float*)(ws + WS_NCUMP))
#define ncumS ((float*)(ws + WS_NCUMS))
#define rss1 ((float*)(ws + WS_RSS))
#define rss2 (((float*)(ws + WS_RSS)) + MT)
#define rss3 (((float*)(ws + WS_RSS)) + 2 * MT)
#define pe_bf ((bf16*)(ws + WS_PE))
#define kr_all ((bf16*)(ws + WS_KR))
#define Wt_in ((bf16*)(ws + WS_WIN))
#define Wt_uq ((bf16*)(ws + WS_WUQ))
#define Wt_ukv ((bf16*)(ws + WS_WUKV))
#define Wt_oa ((bf16*)(ws + WS_WOA))
#define Wt_ob ((bf16*)(ws + WS_WOB))
#define Wt_o ((bf16*)(ws + WS_WO))
#define Wt_up ((bf16*)(ws + WS_WUP))
#define Wt_dn ((bf16*)(ws + WS_WDN))
#define Wt_pg ((bf16*)(ws + WS_WPG))
#define Wt_ple ((bf16*)(ws + WS_WPLE))
#define fk_all ((bf16*)(ws + WS_FK))
#define fv_all ((bf16*)(ws + WS_FV))
#define fq ((bf16*)(ws + WS_FQ))
#define ckv_all ((bf16*)(ws + WS_CKV))
#define cqn ((bf16*)(ws + WS_CQN))
#define Qm ((bf16*)(ws + WS_QM))
#define Km ((bf16*)(ws + WS_KM))
#define Vm ((bf16*)(ws + WS_VM))
#define A0 ((bf16*)(ws + WS_A0))
#define cq_raw ((float*)(ws + WS_CQR))
#define o_a ((bf16*)(ws + WS_OA))
#define o_b ((bf16*)(ws + WS_OB))
#define mg ((bf16*)(ws + WS_MG))
#define hb ((bf16*)(ws + WS_HB))
#define Ubuf ((bf16*)(ws + WS_U))
#define actb ((bf16*)(ws + WS_ACT))
#define hb2 ((bf16*)(ws + WS_HB2))
#define pleo ((bf16*)(ws + WS_PLEO))
#define A0b ((bf16*)(ws + WS_A0B))
#define sga ((bf16*)out)
#define sgb (((bf16*)out) + (size_t)MT * DM)
#define sgS ((bf16*)(ws + WS_SGS))
#define slab ((float*)(ws + WS_SLAB))
#define Uh ((float*)(ws + WS_UH))
#define gw (vcu * NWAVES + wave)
#define NGW (G * NWAVES)
#define gt ((size_t)vcu * (NWAVES * 64) + (size_t)tid)
#define NT ((size_t)G * NWAVES * 64)

#define A0_ROWS(DST, NROWS) do { for (int row = gw; row < (NROWS); row += NGW) { \
            const float* xr = row < MP ? arg_in(I_XP) + (size_t)row * DM : arg_in(I_XS) + (size_t)(row - MP) * DM; \
            f32x4 v[8]; float ss = 0.f; \
            _Pragma("unroll") for (int j = 0; j < 8; ++j) { v[j] = *(const f32x4*)(xr + 4 * lane + 256 * j); ss += (v[j][0] * v[j][0] + v[j][1] * v[j][1]) + (v[j][2] * v[j][2] + v[j][3] * v[j][3]); } \
            const float rs = 1.f / sqrtf(wave_sum(ss) * (1.f / DM) + EPS); \
            _Pragma("unroll") for (int j = 0; j < 8; ++j) { const f32x4 g = *(const f32x4*)(arg_in(I_GMIX) + 4 * lane + 256 * j); *(v2u*)((DST) + (size_t)row * DM + 4 * lane + 256 * j) = pack4(v[j] * rs * g); } } } while (0)

#if defined(REPEAT0)
    for (int rep0 = 0; rep0 < 2; ++rep0)
#endif
    if (IN(0)) {
        LAS float* scr = (LAS float*)(lds + RING_OFF + wave * 16384);
        {
            constexpr int I_IN = 32 * 259, I_UQ = 8 * 48, I_UKV = 8 * 64, I_OA = 16 * 64, I_O = 32 * 64, I_UP = 32 * 352, I_DN = 88 * 64, I_PLE = 4 * 64;
            constexpr int NITEMS = I_IN + I_UQ + I_UKV + 2 * I_OA + 2 * I_O + I_UP + I_DN + I_PLE;
            for (int it = gw; it < NITEMS; it += NGW) {
                int r = it;
                if (r < I_UP) { tr_item<3>(arg_in(I_WUP), DM, DFF2, arg_in(I_GFFN), Wt_up, scr, r, lane); continue; } r -= I_UP;
                if (r < I_IN) { tr_item<1>(arg_in(I_WIN), DM, INW, nullptr, Wt_in, scr, r, lane); continue; } r -= I_IN;
                if (r < I_DN) { tr_item<0>(arg_in(I_WDN), DFF, DM, nullptr, Wt_dn, scr, r, lane); continue; } r -= I_DN;
                if (r < I_O) { tr_item<0>(arg_in(I_WO), DM, DM, nullptr, Wt_o, scr, r, lane); continue; } r -= I_O;
                if (r < I_O) { tr_item<0>(arg_in(I_WPG), DM, DM, arg_in(I_GPLE), Wt_pg, scr, r, lane); continue; } r -= I_O;
                if (r < I_OA) { tr_item<0>(arg_in(I_WOA), FW, DM, nullptr, Wt_oa, scr, r, lane); continue; } r -= I_OA;
                if (r < I_OA) { tr_item<0>(arg_in(I_WOB), FW, DM, nullptr, Wt_ob, scr, r, lane); continue; } r -= I_OA;
                if (r < I_UKV) { tr_item<0>(arg_in(I_WUKV), KVR, NKV, nullptr, Wt_ukv, scr, r, lane); continue; } r -= I_UKV;
                if (r < I_UQ) { tr_item<2>(arg_in(I_WUQ), QR, NQ, nullptr, Wt_uq, scr, r, lane); continue; } r -= I_UQ;
                tr_item<0>(arg_in(I_WPLE), PLE, DM, nullptr, Wt_ple, scr, r, lane);
            }
        }
        A0_ROWS(A0, MT);
#define CVT_LOOP(N8, SRCP, DSTP) do { for (size_t e0 = gt; e0 < (size_t)(N8); e0 += 4 * NT) { f32x4 ca[4], cb[4]; \
            _Pragma("unroll") for (int q = 0; q < 4; ++q) { const size_t e = e0 + q * NT; if (e < (size_t)(N8)) { const size_t e8 = e * 8; const float* sp = (SRCP); ca[q] = *(const f32x4*)sp; cb[q] = *(const f32x4*)(sp + 4); } } \
            _Pragma("unroll") for (int q = 0; q < 4; ++q) { const size_t e = e0 + q * NT; if (e < (size_t)(N8)) { const size_t e8 = e * 8; *(v4u*)(DSTP) = pack8(ca[q], cb[q]); } } } } while (0)
#define CROW(e8, W) ((size_t)(MP + (int)(((e8) / (W)) >> 11) * SKV + (int)(((e8) / (W)) & 2047)) * (W) + ((e8) % (W)))
        CVT_LOOP((size_t)MT * PLE / 8, (e8 < (size_t)MP * PLE ? arg_in(I_PP) + e8 : arg_in(I_PS) + (e8 - (size_t)MP * PLE)), pe_bf + e8);
        CVT_LOOP((size_t)NBS * PAST * KVR / 8, arg_in(I_CCKV) + e8, ckv_all + CROW(e8, KVR));
        CVT_LOOP((size_t)NBS * PAST * ROPE / 8, arg_in(I_CKR) + e8, kr_all + CROW(e8, ROPE));
        { const v4u z = {0u, 0u, 0u, 0u};
          for (size_t e = gt; e < (size_t)184 * DM / 8; e += NT) *(v4u*)(Wt_in + (size_t)1096 * DM + e * 8) = z;
          for (size_t e = gt; e < (size_t)64 * 1024 / 8; e += NT) { *(v4u*)(fk_all + (size_t)RKV * 1024 + e * 8) = z; *(v4u*)(fv_all + (size_t)RKV * 1024 + e * 8) = z; }
          for (size_t e = gt; e < (size_t)64 * 64 / 8; e += NT) *(v4u*)(kr_all + (size_t)RKV * 64 + e * 8) = z;
          for (size_t e = gt; e < (size_t)3 * MT; e += NT) rss1[e] = 0.f; }
        for (size_t e = gt; e < (size_t)TP * 32; e += NT) { const int pos = (int)(e >> 5), i = (int)(e & 31);
            const float inv = (float)pow(10000.0, -(double)i / 32.0); const float ang = (float)pos * inv; ropec[e] = (float)cos((double)ang); ropes[e] = (float)sin((double)ang); }
    }
    SEAM(0);

#if defined(REPEAT1)
    for (int rep1 = 0; rep1 < 2; ++rep1)
#endif
    if (IN(1)) {
        pg8::Gemm g{A0, Wt_in, MT, NIN, DM}; TileOrder S; S.init(MT / 256, NIN / 256, G, bx, 0);
        EpiIn E{out, cq_raw, kr_all, fq, fk_all, fv_all, sga, sgb, ropec, ropes, arg_in(I_BF)};
        pg8::gemm_phase<EpiIn, TileOrder, true, true>(lds + RING_OFF, g, S, E, wave);
    }
    SEAM(1);

    if (IN(2)) {
        for (int row = gw; row < MT; row += NGW) {
            { const float* p = cq_raw + (size_t)row * QR + 4 * lane; const f32x4 a = *(const f32x4*)p, b = *(const f32x4*)(p + 256);
              const float ss = (a[0] * a[0] + a[1] * a[1]) + (a[2] * a[2] + a[3] * a[3]) + (b[0] * b[0] + b[1] * b[1]) + (b[2] * b[2] + b[3] * b[3]);
              const float rs = 1.f / sqrtf(wave_sum(ss) * (1.f / QR) + EPS); const float* gq = arg_in(I_GQ) + 4 * lane;
              *(v2u*)(cqn + (size_t)row * QR + 4 * lane) = pack4(a * rs * *(const f32x4*)gq); *(v2u*)(cqn + (size_t)row * QR + 4 * lane + 256) = pack4(b * rs * *(const f32x4*)(gq + 256)); }
            { float* p = out + O_CKV + (size_t)row * KVR + 4 * lane; const f32x4 a = *(const f32x4*)p, b = *(const f32x4*)(p + 256);
              const float ss = (a[0] * a[0] + a[1] * a[1]) + (a[2] * a[2] + a[3] * a[3]) + (b[0] * b[0] + b[1] * b[1]) + (b[2] * b[2] + b[3] * b[3]);
              const float rs = 1.f / sqrtf(wave_sum(ss) * (1.f / KVR) + EPS); const float* gk = arg_in(I_GKV) + 4 * lane;
              const f32x4 na = a * rs * *(const f32x4*)gk, nb = b * rs * *(const f32x4*)(gk + 256);
              *(f32x4*)p = na; *(f32x4*)(p + 256) = nb; bf16* d = ckv_all + (size_t)kvrow_of(row) * KVR + 4 * lane; *(v2u*)d = pack4(na); *(v2u*)(d + 256) = pack4(nb); }
        }
        { const v4u z = {0u, 0u, 0u, 0u};
          for (size_t e = gt; e < (size_t)64 * 1024 / 8; e += NT) { *(v4u*)(Km + (size_t)RKV * 1024 + e * 8) = z; *(v4u*)(Vm + (size_t)RKV * 1024 + e * 8) = z; } }
    }
    SEAM(2);

    if (IN(3)) {
        { pg8::Gemm g{cqn, Wt_uq, MT, NQ, QR}; TileOrder S; S.init(MT / 256, NQ / 256, G, bx, 0); EpiQ E{Qm, ropec, ropes};
          pg8::gemm_phase<EpiQ, TileOrder, true, true>(lds + RING_OFF, g, S, E, wave); }
        { pg8::Gemm g{ckv_all, Wt_ukv, RKV, NKV, KVR}; TileOrder S; S.init(RKV / 256, NKV / 256, G, bx, 0); EpiKV E{Km, Vm};
          pg8::gemm_phase<EpiKV, TileOrder, true, true>(lds + RING_OFF, g, S, E, wave); }
        {
            float qm = 0.f, km = 0.f;
            for (int r = gw; r < 2 * MT; r += NGW) { const bool isq = r < MT; const bf16* p = (isq ? fq + (size_t)r * FW : fk_all + (size_t)kvrow_of(r - MT) * FW) + 16 * lane;
                f32x4 a0, a1, b0, b1; unpack8(*(const v4u*)p, a0, a1); unpack8(*(const v4u*)(p + 8), b0, b1);
                float ss = (a0[0] * a0[0] + a0[1] * a0[1]) + (a0[2] * a0[2] + a0[3] * a0[3]) + (a1[0] * a1[0] + a1[1] * a1[1]) + (a1[2] * a1[2] + a1[3] * a1[3])
                         + (b0[0] * b0[0] + b0[1] * b0[1]) + (b0[2] * b0[2] + b0[3] * b0[3]) + (b1[0] * b1[0] + b1[1] * b1[1]) + (b1[2] * b1[2] + b1[3] * b1[3]);
                ss += __shfl_xor(ss, 1); ss += __shfl_xor(ss, 2); ss += __shfl_xor(ss, 4);
                if (isq) qm = fmaxf(qm, ss); else km = fmaxf(km, ss); }
            for (int r = gw; r < NBS * PAST; r += NGW) { const float* p = arg_in(I_CFK) + (size_t)r * FW + 16 * lane;
                const f32x4 a0 = *(const f32x4*)p, a1 = *(const f32x4*)(p + 4), b0 = *(const f32x4*)(p + 8), b1 = *(const f32x4*)(p + 12);
                float ss = (a0[0] * a0[0] + a0[1] * a0[1]) + (a0[2] * a0[2] + a0[3] * a0[3]) + (a1[0] * a1[0] + a1[1] * a1[1]) + (a1[2] * a1[2] + a1[3] * a1[3])
                         + (b0[0] * b0[0] + b0[1] * b0[1]) + (b0[2] * b0[2] + b0[3] * b0[3]) + (b1[0] * b1[0] + b1[1] * b1[1]) + (b1[2] * b1[2] + b1[3] * b1[3]);
                ss += __shfl_xor(ss, 1); ss += __shfl_xor(ss, 2); ss += __shfl_xor(ss, 4);
                km = fmaxf(km, ss); }
#pragma unroll
            for (int o_ = 8; o_ < 64; o_ <<= 1) { qm = fmaxf(qm, __shfl_xor(qm, o_)); km = fmaxf(km, __shfl_xor(km, o_)); }
            if (lane == 0) { __hip_atomic_fetch_max((unsigned*)(ctl + CW_QKMAX), __builtin_bit_cast(unsigned, qm), RLX_AGENT); __hip_atomic_fetch_max((unsigned*)(ctl + CW_QKMAX + 64), __builtin_bit_cast(unsigned, km), RLX_AGENT); } }
        if (vcu >= G - (NBP + NBS)) {
            LAS float* part = (LAS float*)(lds + RING_OFF);
            const int cw = vcu - (G - (NBP + NBS)); const bool smp = cw >= NBP; const int b = smp ? cw - NBP : cw, h = tid & 7, c = tid >> 3;
            const int L = smp ? 65 : 64, nchunk = smp ? 32 : 64, t0 = c * L;
            const float* lf_new = out + O_LF + (size_t)(smp ? MP + b * TS : b * TP) * NH; const float* lf_old = arg_in(I_CLF) + (size_t)b * PAST * NH;
            float s = 0.f, lmax = -1.f;
            if (c < nchunk) for (int i = 0; i < L; ++i) { const int t = t0 + i; const float v = smp ? (t < PAST ? lf_old[(size_t)t * NH + h] : lf_new[(size_t)(t - PAST) * NH + h]) : lf_new[(size_t)t * NH + h]; s += v; lmax = fmaxf(lmax, v); }
            if (lmax > 0.f) __hip_atomic_fetch_max((unsigned*)(ctl + CW_QKMAX), 0x7f000000u, RLX_AGENT);
            part[c * 8 + h] = s; __syncthreads();
            float run = 0.f; for (int cc = 0; cc < c; ++cc) run += part[cc * 8 + h];
            float* dst = smp ? ncumS + (size_t)(b * NH + h) * SCUM : ncumP + (size_t)(b * NH + h) * TP;
            if (c < nchunk) for (int i = 0; i < L; ++i) { const int t = t0 + i; run += smp ? (t < PAST ? lf_old[(size_t)t * NH + h] : lf_new[(size_t)(t - PAST) * NH + h]) : lf_new[(size_t)t * NH + h]; dst[t] = -run * LOG2E; }
            if (smp && c >= 32 && c < 36) { for (int i = 0; i < 8; ++i) dst[SKV + (c - 32) * 8 + i] = 0.f; }
            __syncthreads();
        }
        }
    SEAM(3);

    if (IN(4)) {
#ifndef NO_MLA
        { const att::Tensors T{Qm, Km, Vm, kr_all, ncumP, ncumS, o_a, (const unsigned*)(ctl + CW_QKMAX), nullptr, nullptr, nullptr, nullptr}; att::attn_phase<false>(T, ctl + CW_QA, lds + RING_OFF, MISC, wave); }
#endif
#ifndef NO_FOX
        { const att::Tensors T{fq, fk_all, fv_all, kr_all, ncumP, ncumS, o_b, (const unsigned*)(ctl + CW_QKMAX), arg_in(I_CFK), arg_in(I_CFV), out + O_FK, out + O_FV}; att::attn_phase<true>(T, ctl + CW_QB, lds + RING_OFF, MISC, wave); }
#endif
    }
#if defined(REPEAT4)
    { if (IN(4)) xcd_barrier(bar);
      { const att::Tensors T{Qm, Km, Vm, kr_all, ncumP, ncumS, o_a, (const unsigned*)(ctl + CW_QKMAX), nullptr, nullptr, nullptr, nullptr}; att::attn_phase<false>(T, ctl + CW_QA + 128, lds + RING_OFF, MISC, wave); }
      { const att::Tensors T{fq, fk_all, fv_all, kr_all, ncumP, ncumS, o_b, (const unsigned*)(ctl + CW_QKMAX), arg_in(I_CFK), arg_in(I_CFV), out + O_FK, out + O_FV}; att::attn_phase<true>(T, ctl + CW_QB + 128, lds + RING_OFF, MISC, wave); } }
#endif
    SEAM(4);

    if (IN(7)) {
        { pg8::Gemm g{o_a, Wt_oa, MT, DM, FW}; TileOrder S; S.init(MT / 256, DM / 256, G, bx, 0); EpiGate<false> E{sga, sga + (size_t)MP * DM, mg};
          pg8::gemm_phase<EpiGate<false>, TileOrder, ALIGN_HEAVY, true>(lds + RING_OFF, g, S, E, wave); }
        { pg8::Gemm g{o_b, Wt_ob, MT, DM, FW}; TileOrder S; S.init(MT / 256, DM / 256, G, bx, 0);
#if defined(DBG_NORAW)
          EpiGate<false> E{sgb, sgb + (size_t)MP * DM, hb};
#else
          EpiGate<true> E{sgb, sgb + (size_t)MP * DM, mg};
#endif
          #if defined(DBG_NORAW)
          pg8::gemm_phase<EpiGate<false>, TileOrder, ALIGN_HEAVY, true>(lds + RING_OFF, g, S, E, wave); }
#else
          pg8::gemm_phase<EpiGate<true>, TileOrder, ALIGN_HEAVY, true>(lds + RING_OFF, g, S, E, wave); }
#endif
    }
    SEAM(7);

    if (IN(8)) {
#define P8_WO() do { pg8::Gemm g{mg, Wt_o, MT, DM, DM}; TileOrder S; S.init(MT / 256, DM / 256, G, bx, 0); EpiRes<0> E{arg_in(I_XP), arg_in(I_XS), nullptr, nullptr, hb, rss1, nullptr, nullptr}; \
        pg8::gemm_phase<EpiRes<0>, TileOrder, ALIGN_HEAVY, true>(lds + RING_OFF, g, S, E, wave); } while (0)
#define P8_PLE() do { int kple = PLE; asm volatile("" : "+s"(kple)); pg8::Gemm g2{pe_bf, Wt_ple, MT, DM, kple}; TileOrder S2; S2.init(MT / 256, DM / 256, G - 16, bx >= 16 ? bx - 16 : (1 << 28), 0); EpiPle E2{pleo}; \
        pg8::gemm_phase<EpiPle, TileOrder, true, true>(lds + RING_OFF, g2, S2, E2, wave); } while (0)
        if (bx & 1) { P8_PLE(); P8_WO(); } else { P8_WO(); P8_PLE(); }
#undef P8_WO
#undef P8_PLE
    }
    SEAM(8);

    {
        constexpr int ch = 0;
        constexpr int pm0 = ch * CHUNK_TILES, row0 = pm0 * 256;
        if (IN(9 + 3 * ch)) {
            pg8::Gemm g{hb, Wt_up, MT, DFF2, DM}; TileOrder S; S.init(CHUNK_TILES, DFF2 / 256, G, bx, pm0);
            EpiUpAct E{actb, out, rss1, arg_in(I_WCONV), arg_in(I_BCONV), Uh, (LAS unsigned*)(lds + HALO_OFF), row0};
            pg8::gemm_phase<EpiUpAct, TileOrder, true, true>(lds + RING_OFF, g, S, E, wave);
        }
        SEAM(9 + 3 * ch);
        if (IN(11 + 3 * ch)) {
            if (bx & 1) {
                pg8::Gemm gs{hb, Wt_up, MT, DFF2, DM}; TileOrder Ss; Ss.init(MT / 256 - 128, DFF2 / 256, G / 2, bx >> 1, 128);
                EpiUp Es{Ubuf, out, rss1, MP};
                pg8::gemm_phase<EpiUp, TileOrder, true, true>(lds + RING_OFF, gs, Ss, Es, wave);
            }
            pg8::Gemm g{actb - (size_t)row0 * DFF, Wt_dn, MT, DM, DFF}; TileOrder S; S.init(CHUNK_TILES, DM / 256, G, bx, pm0);
                {
                    pg8::Unit fu; const float* wc_ = arg_in(I_WCONV); const float* bc_ = arg_in(I_BCONV);
                    for (int i = 0; S.next(i, fu); ++i) { if ((fu.pm & 15) == 0) continue;
                        const float* u2 = Uh + ((size_t)(fu.pm - 1) * 4 + 2) * DFF2; const float* u0 = Uh + (size_t)fu.pm * 4 * DFF2;
                        for (int j = tid; j < DFF; j += NWAVES * 64) { const int jp = (j >> 7) * 256 + (j & 127);
                            float x[2][4];
#pragma unroll
                            for (int bj = 0; bj < 2; ++bj) { x[bj][0] = u2[jp + bj * 128]; x[bj][1] = u2[DFF2 + jp + bj * 128]; x[bj][2] = u0[jp + bj * 128]; x[bj][3] = u0[DFF2 + jp + bj * 128]; }
#pragma unroll
                            for (int q = 0; q < 2; ++q) { float cvv[2];
#pragma unroll
                                for (int bj = 0; bj < 2; ++bj) { const int col = bj * DFF + j; cvv[bj] = bc_[col] + wc_[col] * x[bj][q] + wc_[DFF2 + col] * x[bj][q + 1] + wc_[2 * DFF2 + col] * x[bj][q + 2]; }
                                const float xg = cvv[1], z = xg + 0.044715f * xg * xg * xg;
                                actb[(size_t)(fu.pm * 256 + q - row0) * DFF + j] = (bf16)f2bf(cvv[0] * xg * __builtin_amdgcn_rcpf(1.f + __builtin_amdgcn_exp2f(-2.f * 0.7978845608028654f * LOG2E * z))); } } }
                    VM_WAIT(); __syncthreads(); }
            EpiRes<1> E{nullptr, nullptr, hb, nullptr, hb2, rss2, nullptr, nullptr};
            pg8::gemm_phase<EpiRes<1>, TileOrder, ALIGN_HEAVY, true>(lds + RING_OFF, g, S, E, wave);
        }
        SEAM(11 + 3 * ch);
    }
    {
        constexpr int ch = NCHUNK - 1, pm0 = ch * CHUNK_TILES, ntile = MT / 256 - pm0, row0 = pm0 * 256, nrows = ntile * 256;
#if defined(REPEAT_ACT)
        for (int repa = 0; repa < 2; ++repa)
#endif
        if (IN(10 + 3 * ch)) {
            const size_t nitem = (size_t)(nrows / 32) * (DFF / 8);
            for (size_t it = gt; it < nitem; it += NT) {
                const int rb = (int)(it / (DFF / 8)), cg = (int)(it % (DFF / 8)), c0 = cg * 8, r0 = row0 + rb * 32;
                f32x4 wv[3][2], wg[3][2], bv[2], bg[2];
#pragma unroll
                for (int k = 0; k < 3; ++k) { const float* w = arg_in(I_WCONV) + (size_t)k * DFF2 + c0; wv[k][0] = *(const f32x4*)w; wv[k][1] = *(const f32x4*)(w + 4); wg[k][0] = *(const f32x4*)(w + DFF); wg[k][1] = *(const f32x4*)(w + DFF + 4); }
                { const float* bb = arg_in(I_BCONV) + c0; bv[0] = *(const f32x4*)bb; bv[1] = *(const f32x4*)(bb + 4); bg[0] = *(const f32x4*)(bb + DFF); bg[1] = *(const f32x4*)(bb + DFF + 4); }
                f32x4 v2[2], v1[2], g2[2], g1[2];
                const bf16* up = Ubuf + (size_t)(r0 - row0) * DFF2 + (c0 >> 7) * 256 + (c0 & 127);
#define GOFF 128
                if (r0 >= MP) { const float* st = arg_in(I_CONV) + (size_t)((r0 - MP) >> 5) * 2 * DFF2 + c0;
                    v2[0] = *(const f32x4*)st; v2[1] = *(const f32x4*)(st + 4); g2[0] = *(const f32x4*)(st + DFF); g2[1] = *(const f32x4*)(st + DFF + 4);
                    v1[0] = *(const f32x4*)(st + DFF2); v1[1] = *(const f32x4*)(st + DFF2 + 4); g1[0] = *(const f32x4*)(st + DFF2 + DFF); g1[1] = *(const f32x4*)(st + DFF2 + DFF + 4); }
                else if ((r0 & (TP - 1)) == 0) { const f32x4 z = {0.f, 0.f, 0.f, 0.f}; v2[0] = v2[1] = v1[0] = v1[1] = g2[0] = g2[1] = g1[0] = g1[1] = z; }
                else { unpack8(*(const v4u*)(up - 2 * DFF2), v2[0], v2[1]); unpack8(*(const v4u*)(up - 2 * DFF2 + GOFF), g2[0], g2[1]); unpack8(*(const v4u*)(up - DFF2), v1[0], v1[1]); unpack8(*(const v4u*)(up - DFF2 + GOFF), g1[0], g1[1]); }
                bf16* ap = actb + (size_t)(r0 - row0) * DFF + c0;
#pragma unroll 8
                for (int r = 0; r < 32; ++r) {
                    f32x4 v0[2], g0[2]; unpack8(*(const v4u*)(up + (size_t)r * DFF2), v0[0], v0[1]); unpack8(*(const v4u*)(up + (size_t)r * DFF2 + GOFF), g0[0], g0[1]);
                    f32x4 o[2];
#pragma unroll
                    for (int q = 0; q < 2; ++q) { const f32x4 cv = bv[q] + wv[0][q] * v2[q] + wv[1][q] * v1[q] + wv[2][q] * v0[q], cgt = bg[q] + wg[0][q] * g2[q] + wg[1][q] * g1[q] + wg[2][q] * g0[q];
#pragma unroll
                        for (int k = 0; k < 4; ++k) { const float x = cgt[k]; const float z = x + 0.044715f * x * x * x;
                            o[q][k] = cv[k] * x * __builtin_amdgcn_rcpf(1.f + __builtin_amdgcn_exp2f(-2.f * 0.7978845608028654f * LOG2E * z)); }
                        v2[q] = v1[q]; v1[q] = v0[q]; g2[q] = g1[q]; g1[q] = g0[q]; }
                    *(v4u*)(ap + (size_t)r * DFF) = pack8(o[0], o[1]);
                }
            }
        }
        SEAM(10 + 3 * ch);
        if (IN(11 + 3 * ch)) {
            pg8::Gemm g{actb - (size_t)row0 * DFF, Wt_dn, MT, DM, DFF / KSPLIT, DFF}; SplitKOrder S; S.init(G, bx);
            EpiSlab E{slab};
            pg8::gemm_phase<EpiSlab, SplitKOrder, true, true>(lds + RING_OFF, g, S, E, wave);
        }
        SEAM(11 + 3 * ch);
    }

    if (IN(18)) {
        for (int r = gw; r < MS; r += NGW) { const int row = MP + r; const bf16* hp = hb + (size_t)row * DM + 4 * lane; f32x4 v[8]; float ss = 0.f;
#pragma unroll
            for (int j = 0; j < 8; ++j) { const v2u w = *(const v2u*)(hp + 256 * j);
                v[j][0] = __builtin_bit_cast(float, w.x << 16); v[j][1] = __builtin_bit_cast(float, w.x & 0xffff0000u); v[j][2] = __builtin_bit_cast(float, w.y << 16); v[j][3] = __builtin_bit_cast(float, w.y & 0xffff0000u);
#pragma unroll
                for (int ks = 0; ks < KSPLIT; ++ks) v[j] += *(const f32x4*)(slab + ((size_t)ks * MS + r) * DM + 4 * lane + 256 * j);
                ss += (v[j][0] * v[j][0] + v[j][1] * v[j][1]) + (v[j][2] * v[j][2] + v[j][3] * v[j][3]); }
            ss = wave_sum(ss);
#pragma unroll
            for (int j = 0; j < 8; ++j) *(v2u*)(hb2 + (size_t)row * DM + 4 * lane + 256 * j) = pack4(v[j]);
            if (lane == 0) rss2[row] = ss; }
    }
    SEAM(18);
    if (IN(19)) {
        pg8::Gemm g{hb2, Wt_pg, MT, DM, DM}; TileOrder S; S.init(MT / 256, DM / 256, G, bx, 0);
        EpiRes<2> E{nullptr, nullptr, hb2, out, nullptr, rss3, rss2, pleo};
        pg8::gemm_phase<EpiRes<2>, TileOrder, ALIGN_HEAVY, true>(lds + RING_OFF, g, S, E, wave);
    }
    SEAM(19);
#if defined(DBG_DUMP)
    if (lo <= 20 && 20 < hi) {
        for (size_t e = gt; e < (size_t)MT * DM / 8; e += NT) { const size_t e8 = e * 8; const int row = (int)(e8 / DM), c = (int)(e8 % DM);
            f32x4 a, b;
#if DBG_DUMP == 1
            unpack8(*(const v4u*)((c < 1024 ? o_a : o_b) + (size_t)row * 1024 + (c & 1023)), a, b);
#elif DBG_DUMP == 2
            unpack8(*(const v4u*)(mg + e8), a, b);
#if defined(DBG_NORAW)
            { f32x4 a2, b2; unpack8(*(const v4u*)(hb + e8), a2, b2); a += a2; b += b2; }
#endif
#elif DBG_DUMP == 6
            unpack8(*(const v4u*)(sga + e8), a, b);
#elif DBG_DUMP == 7
            unpack8(*(const v4u*)(sgb + e8), a, b);
#elif DBG_DUMP == 8
            unpack8(*(const v4u*)(A0b + e8), a, b);
#elif DBG_DUMP == 9
            unpack8(*(const v4u*)(Wt_in + (size_t)4352 * DM + (e8 % ((size_t)4096 * DM))), a, b);
#elif DBG_DUMP == 3
            unpack8(*(const v4u*)(hb + e8), a, b);
#elif DBG_DUMP == 4
            if (c < 512) unpack8(*(const v4u*)(cqn + (size_t)row * 512 + c), a, b); else if (c < 1536) unpack8(*(const v4u*)(fq + (size_t)row * 1024 + (c - 512)), a, b); else unpack8(*(const v4u*)(pe_bf + (size_t)row * 256 + ((c - 1536) & 255)), a, b);
#elif DBG_DUMP == 5
            if (c < 1536) unpack8(*(const v4u*)(Qm + (size_t)row * 1536 + c), a, b); else unpack8(*(const v4u*)(Km + (size_t)row * 1024 + (c - 1536)), a, b);
#endif
            *(f32x4*)(out + e8) = a; *(f32x4*)(out + e8 + 4) = b; }
#if !defined(DBG_KEEP_CONV)
        for (size_t e = gt; e < (O_END - O_CVP); e += NT) out[O_CVP + e] = 0.f;
#endif
    }
#else
    if (IN(20)) {
        for (int row = gw; row < MT; row += NGW) {
            float* p = out + (size_t)row * DM + 4 * lane; const float rs = 1.f / sqrtf(rss3[row] * (1.f / DM) + EPS);
#pragma unroll
            for (int j = 0; j < 8; ++j) { const f32x4 v = *(const f32x4*)(p + 256 * j), g = *(const f32x4*)(arg_in(I_GFIN) + 4 * lane + 256 * j); *(f32x4*)(p + 256 * j) = v * rs * g; }
        }
    }
#endif
#undef IN
#undef SEAM
}

#undef tid
#undef lane
#undef gw
#undef NGW
#undef gt
#undef NT
#ifndef MK_PER_PHASE
#define MK_PER_PHASE 0
#endif
extern "C" void kernel_launch(void* const* d_in, const int* in_sizes, int n_in, void* d_out, int out_size, void* d_ws, size_t ws_size, hipStream_t stream) {
    static int grid = 0;
    if (grid == 0) {
        if (n_in != 29 || in_sizes[0] != MP * DM || (size_t)out_size != O_END || ws_size < WS_END) {
            fprintf(stderr, "kernel_launch: shape mismatch: n_in %d in0 %d out %d ws %zu (need %zu)\n", n_in, n_in > 0 ? in_sizes[0] : -1, out_size, ws_size, (size_t)WS_END); grid = -1; return; }
        int dev = 0, cus = 0, per_cu = 0;
        if (hipGetDevice(&dev) != hipSuccess || hipDeviceGetAttribute(&cus, hipDeviceAttributeMultiprocessorCount, dev) != hipSuccess) { grid = -1; return; }
        if (hipFuncSetAttribute((const void*)mega_fwd, hipFuncAttributeMaxDynamicSharedMemorySize, LDS_BYTES) != hipSuccess) { fprintf(stderr, "kernel_launch: hipFuncSetAttribute failed\n"); grid = -1; return; }
        if (hipOccupancyMaxActiveBlocksPerMultiprocessor(&per_cu, (const void*)mega_fwd, NWAVES * 64, LDS_BYTES) != hipSuccess || per_cu < 1)
            fprintf(stderr, "kernel_launch: note: occupancy query reports %d workgroups per CU\n", per_cu);
        (void)hipGetLastError();
        grid = cus;
    }
    if (grid < 0) return;
    if (hipMemsetAsync((char*)d_ws + WS_CTL, 0, CTL_ZERO_BYTES, stream) != hipSuccess) { fprintf(stderr, "kernel_launch: memset failed\n"); return; }
    Args a{};
    for (int i = 0; i < 29; ++i) a.in[i] = (const float*)d_in[i];
    a.out = (float*)d_out; a.ws = (unsigned char*)d_ws;
#if MK_PER_PHASE
    for (int p = 0; p < NPHASE; ++p) { a.ph_lo = p; a.ph_hi = p + 1; hipLaunchKernelGGL(mega_fwd, dim3(grid), dim3(NWAVES * 64), LDS_BYTES, stream, a); }
#else
    a.ph_lo = 0; a.ph_hi = NPHASE;
    hipLaunchKernelGGL(mega_fwd, dim3(grid), dim3(NWAVES * 64), LDS_BYTES, stream, a);
#endif
    const hipError_t le = hipPeekAtLastError();
    if (le != hipSuccess) fprintf(stderr, "kernel_launch: launch failed: %s\n", hipGetErrorName(le));
}
```
